# Optimizing an MI355X kernel written in HIP

```python
import math
import jax, jax.numpy as jnp
from jax import lax
import numpy as np

D_MODEL = 1024
BATCH = 16
SEQ = 2048
DEPTH = 2

N_A_LAYERS = DEPTH // 2
N_B_LAYERS = DEPTH - N_A_LAYERS
S5_GROUP = 16
S5_GROUPS = D_MODEL // S5_GROUP
S5_STATE = 64
SB_HEAD_DIM = 64
SB_HEADS = D_MODEL // SB_HEAD_DIM
D_FF = 4 * D_MODEL
Q_BLOCK = 128
EPS = 1e-6
DT_MIN = 1e-3
DT_MAX = 1e-1

kernel_name = "yoco_s5_stickbreaking_hybrid"


def rms_norm(x, g):
    xf = x.astype(jnp.float32)
    y = xf * lax.rsqrt(jnp.mean(xf * xf, axis=-1, keepdims=True) + EPS)
    return (y * g.astype(jnp.float32)).astype(x.dtype)


def modulate(h, shift, scale):
    return h * (1 + scale[:, None, :]) + shift[:, None, :]


def ada_chunks(c, w, b, n):
    m = jnp.einsum('bd,de->be', jax.nn.silu(c), w) + b
    return jnp.split(m, n, axis=-1)


def _ssm_combine(left, right):
    a1r, a1i, b1r, b1i = left
    a2r, a2i, b2r, b2i = right
    ar = a2r * a1r - a2i * a1i
    ai = a2r * a1i + a2i * a1r
    br = a2r * b1r - a2i * b1i + b2r
    bi = a2r * b1i + a2i * b1r + b2i
    return ar, ai, br, bi


def s5_mixer(u, a_re, a_im, log_dt, b_re, b_im, c_re, c_im, d_skip):
    bsz, seq, _ = u.shape
    f32 = jnp.float32
    uf = u.astype(f32).reshape(bsz, seq, S5_GROUPS, S5_GROUP)
    lam_re = a_re.astype(f32)
    lam_im = a_im.astype(f32)
    dt = jnp.exp(log_dt.astype(f32))[:, None]
    mag = jnp.exp(lam_re * dt)
    ab_re = mag * jnp.cos(lam_im * dt)
    ab_im = mag * jnp.sin(lam_im * dt)
    den = lam_re * lam_re + lam_im * lam_im
    nr = ab_re - 1
    ni = ab_im
    f_re = (nr * lam_re + ni * lam_im) / den
    f_im = (ni * lam_re - nr * lam_im) / den
    br = b_re.astype(f32)
    bi = b_im.astype(f32)
    bb_re = f_re[..., None] * br - f_im[..., None] * bi
    bb_im = f_re[..., None] * bi + f_im[..., None] * br
    bu_re = jnp.einsum('bsgh,gph->bsgp', uf, bb_re)
    bu_im = jnp.einsum('bsgh,gph->bsgp', uf, bb_im)
    a_seq_re = jnp.broadcast_to(ab_re, (1, seq) + ab_re.shape)
    a_seq_im = jnp.broadcast_to(ab_im, (1, seq) + ab_im.shape)
    _, _, st_re, st_im = lax.associative_scan(
        _ssm_combine, (a_seq_re, a_seq_im, bu_re, bu_im), axis=1)
    y = (jnp.einsum('bsgp,ghp->bsgh', st_re, c_re.astype(f32))
         - jnp.einsum('bsgp,ghp->bsgh', st_im, c_im.astype(f32)))
    y = y.reshape(bsz, seq, D_MODEL) + d_skip.astype(f32) * u.astype(f32)
    return y.astype(u.dtype)


def stick_breaking_attention(q, k, v):
    seq = q.shape[2]
    scale = 1.0 / math.sqrt(SB_HEAD_DIM)
    outs = []
    for t0 in range(0, seq, Q_BLOCK):
        t1 = t0 + Q_BLOCK
        qb = q[:, :, t0:t1]
        kb = k[:, :, :t1]
        vb = v[:, :, :t1]
        z = jnp.einsum('bhtd,bhsd->bhts', qb, kb).astype(jnp.float32) * scale
        t_idx = jnp.arange(t0, t1)[:, None]
        s_idx = jnp.arange(t1)[None, :]
        strict = s_idx < t_idx
        log_fail = jnp.where(strict, jax.nn.log_sigmoid(-z), 0.0)
        rev = lax.cumsum(log_fail, axis=3, reverse=True)
        after = jnp.concatenate([rev[..., 1:], jnp.zeros_like(rev[..., :1])], axis=-1)
        w = jnp.where(strict, jnp.exp(jax.nn.log_sigmoid(z) + after), 0.0)
        outs.append(jnp.einsum('bhts,bhsd->bhtd', w.astype(v.dtype), vb))
    return jnp.concatenate(outs, axis=2)


def split_heads(t):
    bsz, seq, _ = t.shape
    return t.reshape(bsz, seq, SB_HEADS, SB_HEAD_DIM)


def setup_inputs(seed: int = 0) -> dict:
    key = jax.random.key(seed)
    ks = jax.random.split(key, 32)
    f32 = jnp.float32
    D = D_MODEL
    G, P, H = S5_GROUPS, S5_STATE, S5_GROUP
    nrm = lambda k, shape, std: jax.random.normal(k, shape, f32) * std
    x = jax.random.normal(ks[0], (BATCH, SEQ, D), f32)
    c = jax.random.normal(ks[1], (BATCH, D), f32)
    ada_w = nrm(ks[2], (DEPTH, D, 6 * D), 0.5 * D ** -0.5)
    ada_b = nrm(ks[3], (DEPTH, 6 * D), 0.02)
    mix_norm_g = 1.0 + nrm(ks[4], (DEPTH, D), 0.02)
    mlp_norm_g = 1.0 + nrm(ks[5], (DEPTH, D), 0.02)
    mlp_w1 = nrm(ks[6], (DEPTH, D, D_FF), D ** -0.5)
    mlp_w2 = nrm(ks[7], (DEPTH, D_FF, D), D_FF ** -0.5)
    s5_a_re = -0.5 + nrm(ks[8], (N_A_LAYERS, G, P), 0.01)
    s5_a_im = (jnp.float32(math.pi) * jnp.arange(P, dtype=f32))[None, None, :] + nrm(ks[9], (N_A_LAYERS, G, P), 0.01)
    s5_log_dt = jax.random.uniform(ks[10], (N_A_LAYERS, G), f32, math.log(DT_MIN), math.log(DT_MAX))
    s5_b_re = nrm(ks[11], (N_A_LAYERS, G, P, H), (2 * H) ** -0.5)
    s5_b_im = nrm(ks[12], (N_A_LAYERS, G, P, H), (2 * H) ** -0.5)
    s5_c_re = nrm(ks[13], (N_A_LAYERS, G, H, P), P ** -0.5)
    s5_c_im = nrm(ks[14], (N_A_LAYERS, G, H, P), P ** -0.5)
    s5_d = nrm(ks[15], (N_A_LAYERS, D), 1.0)
    s5_w_glu = nrm(ks[16], (N_A_LAYERS, D, 2 * D), D ** -0.5)
    kv_ada_w = nrm(ks[17], (D, 2 * D), 0.5 * D ** -0.5)
    kv_ada_b = nrm(ks[18], (2 * D,), 0.02)
    kv_norm_g = 1.0 + nrm(ks[19], (D,), 0.02)
    w_kv = nrm(ks[20], (D, 2 * D), D ** -0.5)
    k_norm_g = 1.0 + nrm(ks[21], (SB_HEAD_DIM,), 0.02)
    sb_w_q = nrm(ks[22], (N_B_LAYERS, D, D), D ** -0.5)
    q_norm_g = 1.0 + nrm(ks[23], (N_B_LAYERS, SB_HEAD_DIM), 0.02)
    sb_w_o = nrm(ks[24], (N_B_LAYERS, D, D), D ** -0.5)
    return {"x": x, "c": c, "ada_w": ada_w, "ada_b": ada_b,
            "mix_norm_g": mix_norm_g, "mlp_norm_g": mlp_norm_g,
            "mlp_w1": mlp_w1, "mlp_w2": mlp_w2,
            "s5_a_re": s5_a_re, "s5_a_im": s5_a_im, "s5_log_dt": s5_log_dt,
            "s5_b_re": s5_b_re, "s5_b_im": s5_b_im, "s5_c_re": s5_c_re, "s5_c_im": s5_c_im,
            "s5_d": s5_d, "s5_w_glu": s5_w_glu,
            "kv_ada_w": kv_ada_w, "kv_ada_b": kv_ada_b, "kv_norm_g": kv_norm_g,
            "w_kv": w_kv, "k_norm_g": k_norm_g,
            "sb_w_q": sb_w_q, "q_norm_g": q_norm_g, "sb_w_o": sb_w_o}


def reference(x, c, ada_w, ada_b, mix_norm_g, mlp_norm_g, mlp_w1, mlp_w2,
              s5_a_re, s5_a_im, s5_log_dt, s5_b_re, s5_b_im, s5_c_re, s5_c_im,
              s5_d, s5_w_glu, kv_ada_w, kv_ada_b, kv_norm_g, w_kv, k_norm_g,
              sb_w_q, q_norm_g, sb_w_o):
    bsz, seq, _ = x.shape
    k_sh = None
    v_sh = None
    for i in range(DEPTH):
        sh_a, sc_a, g_a, sh_m, sc_m, g_m = ada_chunks(c, ada_w[i], ada_b[i], 6)
        if i < N_A_LAYERS:
            j = i
            h = modulate(rms_norm(x, mix_norm_g[i]), sh_a, sc_a)
            y = s5_mixer(h, s5_a_re[j], s5_a_im[j], s5_log_dt[j], s5_b_re[j], s5_b_im[j],
                         s5_c_re[j], s5_c_im[j], s5_d[j])
            val, gate = jnp.split(jnp.einsum('bsd,de->bse', jax.nn.gelu(y), s5_w_glu[j]), 2, axis=-1)
            mix = val * jax.nn.sigmoid(gate)
        else:
            j = i - N_A_LAYERS
            if j == 0:
                kv_shift, kv_scale = ada_chunks(c, kv_ada_w, kv_ada_b, 2)
                hkv = modulate(rms_norm(x, kv_norm_g), kv_shift, kv_scale)
                k_flat, v_flat = jnp.split(jnp.einsum('bsd,de->bse', hkv, w_kv), 2, axis=-1)
                k_sh = rms_norm(split_heads(k_flat), k_norm_g).transpose(0, 2, 1, 3)
                v_sh = split_heads(v_flat).transpose(0, 2, 1, 3)
            h = modulate(rms_norm(x, mix_norm_g[i]), sh_a, sc_a)
            q = jnp.einsum('bsd,de->bse', h, sb_w_q[j])
            q = rms_norm(split_heads(q), q_norm_g[j]).transpose(0, 2, 1, 3)
            o = stick_breaking_attention(q, k_sh, v_sh)
            o = o.transpose(0, 2, 1, 3).reshape(bsz, seq, D_MODEL)
            mix = jnp.einsum('bsd,de->bse', o, sb_w_o[j])
        x = x + g_a[:, None, :] * mix
        h = modulate(rms_norm(x, mlp_norm_g[i]), sh_m, sc_m)
        ff = jnp.einsum('bsf,fd->bsd', jnp.square(jax.nn.relu(jnp.einsum('bsd,df->bsf', h, mlp_w1[i]))), mlp_w2[i])
        x = x + g_m[:, None, :] * ff
    return x
```

```cpp
#include <hip/hip_runtime.h>
#include <hip/hip_cooperative_groups.h>
#include <cstdio>
#include <cstdint>
namespace cg = cooperative_groups;

#define LAS __attribute__((address_space(3)))
#define DI __device__ __forceinline__
typedef unsigned short bf16_t;
typedef short bf16x8 __attribute__((ext_vector_type(8)));
typedef float f32x2 __attribute__((ext_vector_type(2)));
typedef float f32x4 __attribute__((ext_vector_type(4)));
typedef float f32x16 __attribute__((ext_vector_type(16)));
typedef unsigned u32x2 __attribute__((ext_vector_type(2)));
typedef unsigned u32x4 __attribute__((ext_vector_type(4)));
typedef __bf16 bf16x2_t __attribute__((ext_vector_type(2)));

constexpr int NB = 16, SEQ = 2048, DM = 1024, MTOK = NB * SEQ, FFD = 4096, NG = 64, NP = 64, NHEAD = 16, HD = 64;
constexpr int MODN = 14336;
constexpr float EPS = 1e-6f;
constexpr float QSCALE = 0.125f * 1.4426950408889634f;
constexpr int NWAVES = 8, NTHREADS = 512;
constexpr int LDS_BYTES = 135168;

constexpr size_t MiB = 1u << 20;
constexpr size_t WS_WGLU = 0, WS_W1 = 4 * MiB, WS_W2 = 20 * MiB, WS_WKV = 36 * MiB, WS_WQ = 40 * MiB, WS_WO = 42 * MiB;
constexpr size_t WS_MOD = 44 * MiB, WS_RSTD = 45 * MiB, WS_AB = 45 * MiB + 256 * 1024, WS_BOP = 45 * MiB + 512 * 1024, WS_CM = 45 * MiB + 768 * 1024;
constexpr size_t WS_YG = 48 * MiB, WS_H = 112 * MiB, WS_F = 176 * MiB;
constexpr size_t WS_Q = 176 * MiB, WS_K = 240 * MiB, WS_VT = 304 * MiB, WS_O = 368 * MiB, WS_END = 432 * MiB;

DI unsigned pk2(float lo, float hi) { f32x2 v = {lo, hi}; bf16x2_t b = __builtin_convertvector(v, bf16x2_t); return __builtin_bit_cast(unsigned, b); }
DI float wave_sum(float v) {
#pragma unroll
    for (int o = 1; o < 64; o <<= 1) v += __shfl_xor(v, o);
    return v;
}
#define LDS_WAIT() asm volatile("s_waitcnt lgkmcnt(0)" ::: "memory")

namespace pg8 {
constexpr int BM = 256, BK = 64, HALF = 128, HTB = HALF * BK * 2, STAGE_BYTES = 8 * HTB, NXCD = 8, WGM = 8;
__host__ __device__ __forceinline__ int lds_byte(int r, int c) { const int st = (r >> 4) * 2 + (c >> 5), rr = r & 15, cc = c & 31, ob = rr * 64 + cc * 2; return st * 1024 + (ob ^ (((ob >> 9) & 1) << 5)); }
__host__ __device__ __forceinline__ void stage_rc(int b, int& R, int& C) { const int st = b / 1024, sb = b % 1024, swz = sb ^ (((sb >> 9) & 1) << 5); R = (st >> 1) * 16 + swz / 64; C = (st & 1) * 32 + (swz % 64) / 2; }
__host__ __device__ __forceinline__ int perm32(int rho) { const int n = rho >> 4, i = rho & 15; return 8 * (i >> 2) + 4 * n + (i & 3); }
struct Unit { int pm, pn; };
struct Gemm { const bf16_t* A; const bf16_t* Bt; int M, N, K; };
struct StaticOrder {
    int nM, nN, nwg, G, c;
    __device__ void init(int M, int N, int G_, int c_) { nM = M / BM; nN = N / BM; nwg = nM * nN; G = G_; c = c_; }
    __device__ bool next(int i, Unit& u) const {
        const long L = (long)i * G + c; if (L >= nwg) return false;
        int wgid = (int)L; { const int q = nwg / NXCD, r = nwg % NXCD, xcd = wgid % NXCD, off = wgid / NXCD; wgid = (xcd < r ? xcd * (q + 1) : r * (q + 1) + (xcd - r) * q) + off; }
        const int nig = WGM * nN, gid = wgid / nig, fm = gid * WGM, gsz = (nM - fm) < WGM ? (nM - fm) : WGM;
        u.pm = fm + ((wgid % nig) % gsz); u.pn = (wgid % nig) / gsz; return true;
    }
};
template <class Epi>
__device__ __forceinline__ void gemm_phase(LAS unsigned char* lds, const Gemm g, const StaticOrder& S, const Epi& E) {
    const int tid = threadIdx.x, wid = __builtin_amdgcn_readfirstlane(tid >> 6), lane = tid & 63, wr = wid >> 2, wc = wid & 3, fr = lane & 15, fq = lane >> 4;
    const int K = g.K, nt = K / BK;
    unsigned voffA[2], voffB[2];
#pragma unroll
    for (int i = 0; i < 2; ++i) { int R, C; stage_rc(tid * 16 + i * 8192, R, C); const int Rb = Epi::PERM ? ((R & ~31) + perm32(R & 31)) : R;
        voffA[i] = (unsigned)(R * K + C) * 2u; voffB[i] = (unsigned)(Rb * K + C) * 2u; }
    const size_t kstep = (size_t)(BK * 2);
    const size_t hstep = (size_t)HALF * K * 2;
    const size_t tstep = 2 * hstep;
    const unsigned ldsw = (unsigned)wid * 1024u;
    const int aoff = lds_byte(wr * 64 + fr, fq * 8), boff = lds_byte(wc * 32 + fr, fq * 8);
#define PG8_SA(b, h) (((b) * 2 + (h)) * HTB)
#define PG8_SB(b, h) ((4 + (b) * 2 + (h)) * HTB)
#define PG8_STAGE(bufoff, gbase, voff) do { _Pragma("unroll") for (int _i = 0; _i < 2; ++_i) \
        __builtin_amdgcn_global_load_lds((const unsigned*)((const char*)(gbase) + (voff)[_i]), (LAS unsigned*)(lds + (bufoff) + ldsw + _i * 8192), 16, 0, 0); } while (0)
#define PG8_LDA(dst, b, h) do { _Pragma("unroll") for (int m = 0; m < 4; ++m) _Pragma("unroll") for (int k = 0; k < 2; ++k) dst[m][k] = *(const LAS bf16x8*)(lds + PG8_SA(b, h) + aoff + m * 2048 + k * 1024); } while (0)
#define PG8_LDB(dst, b, h) do { _Pragma("unroll") for (int n = 0; n < 2; ++n) _Pragma("unroll") for (int k = 0; k < 2; ++k) dst[n][k] = *(const LAS bf16x8*)(lds + PG8_SB(b, h) + boff + n * 2048 + k * 1024); } while (0)
#define PG8_MMA(ai, bj, At, Bt) do { __builtin_amdgcn_s_setprio(1); _Pragma("unroll") for (int m = 0; m < 4; ++m) _Pragma("unroll") for (int n = 0; n < 2; ++n) _Pragma("unroll") for (int k = 0; k < 2; ++k) \
        acc[ai][bj][m][n] = __builtin_amdgcn_mfma_f32_16x16x32_bf16(Bt[n][k], At[m][k], acc[ai][bj][m][n], 0, 0, 0); __builtin_amdgcn_s_setprio(0); } while (0)
#define PG8_WAIT_V(n) asm volatile("s_waitcnt vmcnt(" #n ")" ::: "memory")
#define PG8_WAIT_L(n) asm volatile("s_waitcnt lgkmcnt(" #n ")" ::: "memory")
#define PG8_BAR __builtin_amdgcn_s_barrier()
#define PG8_SCHED __builtin_amdgcn_sched_barrier(0)
    Unit cur, nxt; int ui = 0;
    if (!S.next(0, cur)) return;
    f32x4 acc[2][2][4][2];
#pragma unroll
    for (int a = 0; a < 2; ++a)
#pragma unroll
        for (int b = 0; b < 2; ++b)
#pragma unroll
            for (int m = 0; m < 4; ++m)
#pragma unroll
                for (int n = 0; n < 2; ++n) acc[a][b][m][n] = (f32x4){0.f, 0.f, 0.f, 0.f};
    bf16x8 At[4][2], B0[2][2], B1[2][2];
    const char* cA = (const char*)g.A + (size_t)cur.pm * tstep; const char* cB = (const char*)g.Bt + (size_t)cur.pn * tstep;
    PG8_STAGE(PG8_SB(0, 0), cB, voffB); PG8_STAGE(PG8_SB(0, 1), cB + hstep, voffB); PG8_STAGE(PG8_SA(0, 0), cA, voffA); PG8_STAGE(PG8_SA(0, 1), cA + hstep, voffA);
    if (wr == 1) PG8_BAR;
    PG8_WAIT_V(2); PG8_BAR;
    PG8_STAGE(PG8_SB(1, 0), cB + kstep, voffB); PG8_STAGE(PG8_SA(1, 0), cA + kstep, voffA); PG8_STAGE(PG8_SB(1, 1), cB + hstep + kstep, voffB);
    PG8_WAIT_V(6); PG8_BAR;
    for (;;) {
        const bool has_next = S.next(ui + 1, nxt);
        const char* nA = has_next ? (const char*)g.A + (size_t)nxt.pm * tstep : cA; const char* nB = has_next ? (const char*)g.Bt + (size_t)nxt.pn * tstep : cB;
        for (int t = 0; t < nt; t += 2) {
            const bool last = (t == nt - 2);
            const char* a1 = cA + (size_t)(t + 1) * kstep;
            const char* a2 = last ? nA : cA + (size_t)(t + 2) * kstep; const char* b2 = last ? nB : cB + (size_t)(t + 2) * kstep;
            const char* a3 = a2 + kstep; const char* b3 = b2 + kstep;
            PG8_LDB(B0, 0, 0); PG8_LDB(B1, 0, 1); PG8_SCHED; PG8_LDA(At, 0, 0); PG8_STAGE(PG8_SA(1, 1), a1 + hstep, voffA);
            PG8_WAIT_V(8); PG8_WAIT_L(0); PG8_BAR; PG8_MMA(0, 0, At, B0); PG8_MMA(0, 1, At, B1); PG8_BAR; PG8_SCHED;
            PG8_LDA(At, 0, 1); PG8_STAGE(PG8_SB(0, 0), b2, voffB); PG8_STAGE(PG8_SB(0, 1), b2 + hstep, voffB); PG8_STAGE(PG8_SA(0, 0), a2, voffA);
            PG8_WAIT_V(8); PG8_WAIT_L(0); PG8_BAR; PG8_MMA(1, 0, At, B0); PG8_MMA(1, 1, At, B1); PG8_BAR; PG8_SCHED;
            PG8_LDB(B0, 1, 0); PG8_LDB(B1, 1, 1); PG8_SCHED; PG8_LDA(At, 1, 0); PG8_STAGE(PG8_SA(0, 1), a2 + hstep, voffA);
            PG8_WAIT_V(8); PG8_WAIT_L(0); PG8_BAR; PG8_MMA(0, 0, At, B0); PG8_MMA(0, 1, At, B1); PG8_BAR; PG8_SCHED;
            PG8_LDA(At, 1, 1); PG8_STAGE(PG8_SB(1, 0), b3, voffB); PG8_STAGE(PG8_SB(1, 1), b3 + hstep, voffB); PG8_STAGE(PG8_SA(1, 0), a3, voffA);
            PG8_WAIT_V(8); PG8_WAIT_L(0); PG8_BAR; PG8_MMA(1, 0, At, B0); PG8_MMA(1, 1, At, B1); PG8_BAR; PG8_SCHED;
        }
        if (wr == 0) PG8_BAR;
        E(acc, cur, wr, wc, fr, fq);
        if (!has_next) break;
#pragma unroll
        for (int a = 0; a < 2; ++a)
#pragma unroll
            for (int b = 0; b < 2; ++b)
#pragma unroll
                for (int m = 0; m < 4; ++m)
#pragma unroll
                    for (int n = 0; n < 2; ++n) acc[a][b][m][n] = (f32x4){0.f, 0.f, 0.f, 0.f};
        cur = nxt; cA = nA; cB = nB; ++ui;
        if (wr == 1) PG8_BAR;
    }
    PG8_WAIT_V(0);
    PG8_BAR;
#undef PG8_SA
#undef PG8_SB
#undef PG8_STAGE
#undef PG8_LDA
#undef PG8_LDB
#undef PG8_MMA
#undef PG8_WAIT_V
#undef PG8_WAIT_L
#undef PG8_BAR
#undef PG8_SCHED
}

DI float sigmoidf_(float v) { return __builtin_amdgcn_rcpf(1.0f + __builtin_amdgcn_exp2f(-1.4426950408889634f * v)); }

struct EpiGlu {
    static constexpr bool PERM = false;
    const float* x; float* out; const float* ga;
    DI void operator()(const f32x4 (&acc)[2][2][4][2], const Unit& u, int wr, int wc, int fr, int fq) const {
        const int row0 = u.pm * BM + wr * 64 + fr, b = (u.pm * BM) >> 11, col0 = u.pn * 128 + wc * 32 + 4 * fq;
        f32x4 gv[2];
#pragma unroll
        for (int n = 0; n < 2; ++n) gv[n] = *(const f32x4*)(ga + (size_t)b * MODN + col0 + 16 * n);
#pragma unroll
        for (int ai = 0; ai < 2; ++ai)
#pragma unroll
            for (int m = 0; m < 4; ++m) { const size_t ro = (size_t)(row0 + ai * HALF + m * 16) * DM + col0;
#pragma unroll
                for (int n = 0; n < 2; ++n) { const f32x4 xin = *(const f32x4*)(x + ro + 16 * n); const f32x4 v = acc[ai][0][m][n], gt = acc[ai][1][m][n]; f32x4 o;
#pragma unroll
                    for (int j = 0; j < 4; ++j) o[j] = xin[j] + gv[n][j] * v[j] * sigmoidf_(gt[j]);
                    *(f32x4*)(out + ro + 16 * n) = o; } }
    }
};
struct EpiRelu2 {
    static constexpr bool PERM = true;
    bf16_t* O; int ldc;
    DI void operator()(const f32x4 (&acc)[2][2][4][2], const Unit& u, int wr, int wc, int fr, int fq) const {
        const int row0 = u.pm * BM + wr * 64 + fr, col0 = u.pn * BM + wc * 32 + 8 * fq;
#pragma unroll
        for (int ai = 0; ai < 2; ++ai)
#pragma unroll
            for (int m = 0; m < 4; ++m) { bf16_t* rowp = O + (size_t)(row0 + ai * HALF + m * 16) * ldc + col0;
#pragma unroll
                for (int bj = 0; bj < 2; ++bj) { f32x4 v0 = acc[ai][bj][m][0], v1 = acc[ai][bj][m][1];
#pragma unroll
                    for (int j = 0; j < 4; ++j) { const float a = fmaxf(v0[j], 0.f), c = fmaxf(v1[j], 0.f); v0[j] = a * a; v1[j] = c * c; }
                    u32x4 w; w.x = pk2(v0[0], v0[1]); w.y = pk2(v0[2], v0[3]); w.z = pk2(v1[0], v1[1]); w.w = pk2(v1[2], v1[3]);
                    *(u32x4*)(rowp + bj * HALF) = w; } }
    }
};
struct EpiRes {
    static constexpr bool PERM = false;
    float* io; const float* gate;
    DI void operator()(const f32x4 (&acc)[2][2][4][2], const Unit& u, int wr, int wc, int fr, int fq) const {
        const int row0 = u.pm * BM + wr * 64 + fr, b = (u.pm * BM) >> 11, col0 = u.pn * BM + wc * 32 + 4 * fq;
        f32x4 gv[2][2];
#pragma unroll
        for (int bj = 0; bj < 2; ++bj)
#pragma unroll
            for (int n = 0; n < 2; ++n) gv[bj][n] = *(const f32x4*)(gate + (size_t)b * MODN + col0 + bj * HALF + 16 * n);
#pragma unroll
        for (int ai = 0; ai < 2; ++ai)
#pragma unroll
            for (int m = 0; m < 4; ++m) { float* rp = io + (size_t)(row0 + ai * HALF + m * 16) * DM + col0;
#pragma unroll
                for (int bj = 0; bj < 2; ++bj)
#pragma unroll
                    for (int n = 0; n < 2; ++n) { const f32x4 bs = *(const f32x4*)(rp + bj * HALF + 16 * n); *(f32x4*)(rp + bj * HALF + 16 * n) = bs + gv[bj][n] * acc[ai][bj][m][n]; } }
    }
};
template <int MODE> struct EpiHeads {
    static constexpr bool PERM = true;
    bf16_t* Kb; bf16_t* VT; const float* ng;
    DI void operator()(const f32x4 (&acc)[2][2][4][2], const Unit& u, int wr, int wc, int fr, int fq) const {
        const int b = (u.pm * BM) >> 11, s0 = ((u.pm * BM) & (SEQ - 1)) + wr * 64 + fr;
        const bool isV = (MODE == 0) && (u.pn >= 4);
        const int h = 4 * (u.pn & 3) + wc;
        if (!isV) {
            const float gsc = (MODE == 1) ? QSCALE : 1.0f;
#pragma unroll
            for (int ai = 0; ai < 2; ++ai)
#pragma unroll
                for (int m = 0; m < 4; ++m) { float ss = 0.f;
#pragma unroll
                    for (int bj = 0; bj < 2; ++bj)
#pragma unroll
                        for (int n = 0; n < 2; ++n) { const f32x4 v = acc[ai][bj][m][n]; ss += (v[0] * v[0] + v[1] * v[1]) + (v[2] * v[2] + v[3] * v[3]); }
                    ss += __shfl_xor(ss, 16); ss += __shfl_xor(ss, 32);
                    const float rs = __builtin_amdgcn_rsqf(ss * (1.0f / 64.0f) + EPS) * gsc;
                    bf16_t* rp = Kb + ((size_t)(b * NHEAD + h) * SEQ + (s0 + ai * HALF + m * 16)) * HD + 8 * fq;
#pragma unroll
                    for (int bj = 0; bj < 2; ++bj) { const f32x4 g0 = *(const f32x4*)(ng + 32 * bj + 8 * fq), g1 = *(const f32x4*)(ng + 32 * bj + 8 * fq + 4);
                        const f32x4 v0 = acc[ai][bj][m][0] * rs * g0, v1 = acc[ai][bj][m][1] * rs * g1;
                        u32x4 w; w.x = pk2(v0[0], v0[1]); w.y = pk2(v0[2], v0[3]); w.z = pk2(v1[0], v1[1]); w.w = pk2(v1[2], v1[3]);
                        *(u32x4*)(rp + 32 * bj) = w; }
                    asm volatile("" ::: "memory"); }
        } else {
            const unsigned loff = (unsigned)(8 * fq * SEQ + fr);
            bf16_t* ub = VT + (size_t)(b * NHEAD + h) * HD * SEQ + (((u.pm * BM) & (SEQ - 1)) + wr * 64);
#pragma unroll
            for (int ai = 0; ai < 2; ++ai)
#pragma unroll
                for (int m = 0; m < 4; ++m) {
#pragma unroll
                    for (int bj = 0; bj < 2; ++bj)
#pragma unroll
                        for (int n = 0; n < 2; ++n) { const f32x4 v = acc[ai][bj][m][n];
#pragma unroll
                            for (int j = 0; j < 4; ++j) { bf16_t* up = ub + (size_t)(32 * bj + 4 * n + j) * SEQ + (ai * HALF + m * 16); up[loff] = (bf16_t)(pk2(v[j], 0.f) & 0xffffu); } }
                    asm volatile("" ::: "memory"); }
        }
    }
};
}

DI double dexp(double x) {
    const double n = __builtin_rint(x * 1.4426950408889634);
    double r = __builtin_fma(-n, 0.6931471805599453, x); r = __builtin_fma(-n, 2.3190468138462996e-17, r);
    double p = 1.0 / 6227020800.0;
    p = p * r + 1.0 / 479001600.0; p = p * r + 1.0 / 39916800.0; p = p * r + 1.0 / 3628800.0; p = p * r + 1.0 / 362880.0; p = p * r + 1.0 / 40320.0;
    p = p * r + 1.0 / 5040.0; p = p * r + 1.0 / 720.0; p = p * r + 1.0 / 120.0; p = p * r + 1.0 / 24.0; p = p * r + 1.0 / 6.0; p = p * r + 0.5; p = p * r + 1.0; p = p * r + 1.0;
    return __builtin_ldexp(p, (int)n);
}
DI void dsincos(double a, double& s, double& c) {
    const double q = __builtin_rint(a * 0.6366197723675814);
    double r = __builtin_fma(-q, 1.5707963267948966, a); r = __builtin_fma(-q, 6.123233995736766e-17, r);
    const int qi = ((int)q) & 3; const double r2 = r * r;
    double sp = -1.0 / 1307674368000.0; sp = sp * r2 + 1.0 / 6227020800.0; sp = sp * r2 - 1.0 / 39916800.0; sp = sp * r2 + 1.0 / 362880.0; sp = sp * r2 - 1.0 / 5040.0; sp = sp * r2 + 1.0 / 120.0; sp = sp * r2 - 1.0 / 6.0; sp = sp * r2 + 1.0; sp = sp * r;
    double cp = 1.0 / 20922789888000.0; cp = cp * r2 - 1.0 / 87178291200.0; cp = cp * r2 + 1.0 / 479001600.0; cp = cp * r2 - 1.0 / 3628800.0; cp = cp * r2 + 1.0 / 40320.0; cp = cp * r2 - 1.0 / 720.0; cp = cp * r2 + 1.0 / 24.0; cp = cp * r2 - 0.5; cp = cp * r2 + 1.0;
    s = (qi == 0) ? sp : (qi == 1) ? cp : (qi == 2) ? -sp : -cp;
    c = (qi == 0) ? cp : (qi == 1) ? -sp : (qi == 2) ? -cp : sp;
}

DI void transpose_item(const float* __restrict__ W, int K, int N, bf16_t* __restrict__ WT, int k0, int n0, int drow0, LAS float* scr, int lane) {
#pragma unroll 8
    for (int i = 0; i < 32; ++i) { const int kk = 2 * i + (lane >> 5); scr[kk * 33 + (lane & 31)] = W[(size_t)(k0 + kk) * N + n0 + (lane & 31)]; }
    LDS_WAIT();
    const int c = lane & 7;
#pragma unroll
    for (int j = 0; j < 4; ++j) { const int n = (lane >> 3) + 8 * j; const LAS float* s = scr + (8 * c) * 33 + n;
        u32x4 o; o.x = pk2(s[0 * 33], s[1 * 33]); o.y = pk2(s[2 * 33], s[3 * 33]); o.z = pk2(s[4 * 33], s[5 * 33]); o.w = pk2(s[6 * 33], s[7 * 33]);
        *(u32x4*)(WT + (size_t)(drow0 + n) * K + k0 + 8 * c) = o; }
    LDS_WAIT();
}
DI int map_rows(int mode, int n0) {
    if (mode == 1) { const int bj = n0 >> 10, rem = n0 & 1023; return 256 * (rem >> 7) + 128 * bj + (rem & 127); }
    if (mode == 2) { const int tile = n0 >> 8, off = n0 & 255; return 256 * tile + 128 * ((off & 63) >> 5) + 32 * (off >> 6); }
    return n0;
}

struct Args { const float* in[25]; float* out; unsigned char* ws; int ph_lo, ph_hi; };

__global__ void __launch_bounds__(NTHREADS, 2) yoco_fwd(Args args) {
    extern __shared__ __attribute__((aligned(16))) unsigned char lds_raw[];
    LAS unsigned char* lds = (LAS unsigned char*)lds_raw;
    cg::grid_group grid = cg::this_grid();
    const int tid = threadIdx.x, lane = tid & 63, wave = __builtin_amdgcn_readfirstlane(tid >> 6);
    const int G = gridDim.x, blk = blockIdx.x;
    const int gw = blk * NWAVES + wave, NGW = G * NWAVES;
    unsigned char* ws = args.ws;
    const float* x_in = args.in[0];
    float* X = args.out;
    bf16_t* Wglu = (bf16_t*)(ws + WS_WGLU); bf16_t* W1t = (bf16_t*)(ws + WS_W1); bf16_t* W2t = (bf16_t*)(ws + WS_W2);
    bf16_t* Wkv = (bf16_t*)(ws + WS_WKV); bf16_t* Wq = (bf16_t*)(ws + WS_WQ); bf16_t* Wo = (bf16_t*)(ws + WS_WO);
    float* modv = (float*)(ws + WS_MOD); float* rstd0 = (float*)(ws + WS_RSTD);
    f32x2* abv = (f32x2*)(ws + WS_AB); bf16_t* Bop = (bf16_t*)(ws + WS_BOP); bf16_t* Cm = (bf16_t*)(ws + WS_CM);
    bf16_t* Yg = (bf16_t*)(ws + WS_YG); bf16_t* Hb = (bf16_t*)(ws + WS_H); bf16_t* Fb = (bf16_t*)(ws + WS_F);
    bf16_t* Qb = (bf16_t*)(ws + WS_Q); bf16_t* Kb = (bf16_t*)(ws + WS_K); bf16_t* VT = (bf16_t*)(ws + WS_VT); bf16_t* Ob = (bf16_t*)(ws + WS_O);
    const int lo = args.ph_lo, hi_ph = args.ph_hi;
#ifndef PHMASK
#define PHMASK 0x1fff
#endif
#define IN(k) (((PHMASK >> (k)) & 1) && lo <= (k) && (k) < hi_ph)
#define SEAM(k) do { if (IN(k) && IN((k) + 1)) grid.sync(); } while (0)

    if (IN(0)) {
        {
            LAS float* sc = (LAS float*)lds;
            LAS float* red = (LAS float*)(lds + 65536);
            const float* cvec = args.in[1];
            bool have_sc = false;
            for (int cb = blk; cb < MODN / 64; cb += G) {
                if (!have_sc) {
                    for (int i = tid; i < NB * DM; i += NTHREADS) { const float v = cvec[i]; sc[(i & 1023) * 16 + (i >> 10)] = v / (1.0f + __expf(-v)); }
                    __syncthreads(); have_sc = true;
                }
                const int e = cb * 64 + lane;
                const float* Wp; int stride; const float* bias;
                if (e < 12288) { const int l = e / 6144, ee = e - l * 6144; Wp = args.in[2] + (size_t)l * DM * 6144 + ee; stride = 6144; bias = args.in[3] + l * 6144 + ee; }
                else { const int ee = e - 12288; Wp = args.in[17] + ee; stride = 2048; bias = args.in[18] + ee; }
                float a[16];
#pragma unroll
                for (int b = 0; b < 16; ++b) a[b] = 0.f;
                const int d0 = wave * 128;
#pragma unroll 4
                for (int d = 0; d < 128; ++d) { const float w = Wp[(size_t)(d0 + d) * stride];
                    const LAS f32x4* sp = (const LAS f32x4*)(sc + (d0 + d) * 16);
#pragma unroll
                    for (int q = 0; q < 4; ++q) { const f32x4 s4 = sp[q]; a[4 * q] += w * s4[0]; a[4 * q + 1] += w * s4[1]; a[4 * q + 2] += w * s4[2]; a[4 * q + 3] += w * s4[3]; } }
#pragma unroll
                for (int b = 0; b < 16; ++b) red[(wave * 16 + b) * 64 + lane] = a[b];
                __syncthreads();
                for (int o = tid; o < 1024; o += NTHREADS) { const int b = o >> 6, cl = o & 63; float s = 0.f;
#pragma unroll
                    for (int w8 = 0; w8 < 8; ++w8) s += red[(w8 * 16 + b) * 64 + cl];
                    const int ee = cb * 64 + cl; const float bs = (ee < 12288) ? args.in[3][ee] : args.in[18][ee - 12288];
                    modv[(size_t)b * MODN + ee] = s + bs; }
                __syncthreads();
                (void)bias;
            }
            __syncthreads();
        }
        for (int i = blk * NTHREADS + tid; i < NG * NP; i += G * NTHREADS) {
            const int g = i >> 6, p = i & 63;
            const double lre = (double)args.in[8][i], lim = (double)args.in[9][i], dt = dexp((double)args.in[10][g]);
            const double mag = dexp(lre * dt); double sn, cs; dsincos(lim * dt, sn, cs);
            const double are = mag * cs, aim = mag * sn, den = lre * lre + lim * lim, nr = are - 1.0, ni = aim;
            const double fre = (nr * lre + ni * lim) / den, fim = (ni * lre - nr * lim) / den;
            abv[i] = (f32x2){(float)are, (float)aim};
            const float* bre = args.in[11] + (size_t)i * 16; const float* bim = args.in[12] + (size_t)i * 16;
#pragma unroll
            for (int h = 0; h < 16; h += 2) {
                const double br0 = bre[h], bi0 = bim[h], br1 = bre[h + 1], bi1 = bim[h + 1];
                *(unsigned*)(Bop + ((size_t)(g * 128 + 2 * p) * 16 + h)) = pk2((float)(fre * br0 - fim * bi0), (float)(fre * br1 - fim * bi1));
                *(unsigned*)(Bop + ((size_t)(g * 128 + 2 * p + 1) * 16 + h)) = pk2((float)(fre * bi0 + fim * br0), (float)(fre * bi1 + fim * br1));
            }
#pragma unroll
            for (int h = 0; h < 16; ++h) {
                const float cr = args.in[13][(size_t)(g * 16 + h) * 64 + p], ci = args.in[14][(size_t)(g * 16 + h) * 64 + p];
                *(unsigned*)(Cm + ((size_t)(g * 16 + h) * 128 + 2 * p)) = pk2(cr, -ci);
            }
        }
        {
            LAS float* scr = (LAS float*)(lds + wave * 8448);
            constexpr int I_GLU = 16 * 64, I_W1 = 16 * 128, I_W2 = 64 * 32, I_KV = 16 * 64, I_Q = 16 * 32, I_O = 16 * 32;
            constexpr int NITEMS = I_GLU + 2 * I_W1 + 2 * I_W2 + I_KV + I_Q + I_O;
            for (int it = gw; it < NITEMS; it += NGW) {
                int r = it; const float* W; bf16_t* WT; int K, N, mode;
                if (r < I_GLU) { W = args.in[16]; WT = Wglu; K = DM; N = 2 * DM; mode = 1; }
                else if ((r -= I_GLU) < 2 * I_W1) { const int l = r / I_W1; r -= l * I_W1; W = args.in[6] + (size_t)l * DM * FFD; WT = W1t + (size_t)l * DM * FFD; K = DM; N = FFD; mode = 0; }
                else if ((r -= 2 * I_W1) < 2 * I_W2) { const int l = r / I_W2; r -= l * I_W2; W = args.in[7] + (size_t)l * DM * FFD; WT = W2t + (size_t)l * DM * FFD; K = FFD; N = DM; mode = 0; }
                else if ((r -= 2 * I_W2) < I_KV) { W = args.in[20]; WT = Wkv; K = DM; N = 2 * DM; mode = 2; }
                else if ((r -= I_KV) < I_Q) { W = args.in[22]; WT = Wq; K = DM; N = DM; mode = 2; }
                else { r -= I_Q; W = args.in[24]; WT = Wo; K = DM; N = DM; mode = 0; }
                const int nblk = N / 32, kb = r / nblk, nb = r - kb * nblk;
                transpose_item(W, K, N, WT, 64 * kb, 32 * nb, map_rows(mode, 32 * nb), scr, lane);
            }
        }
        for (int row = gw; row < MTOK; row += NGW) {
            const f32x4* xr = (const f32x4*)(x_in + (size_t)row * DM) + lane; float ss = 0.f;
#pragma unroll
            for (int j = 0; j < 4; ++j) { const f32x4 v = xr[64 * j]; ss += (v[0] * v[0] + v[1] * v[1]) + (v[2] * v[2] + v[3] * v[3]); }
            ss = wave_sum(ss);
            if (lane == 0) rstd0[row] = 1.0f / sqrtf(ss * (1.0f / DM) + EPS);
        }
    }
    SEAM(0);

    if (IN(1)) {
        if (wave < 4) {
            LAS float* BUl = (LAS float*)(lds + wave * 24576);
            LAS unsigned* Sl = (LAS unsigned*)(lds + wave * 24576 + 16384);
            const int r32 = lane & 31, hi = lane >> 5, fr = lane & 15, fq = lane >> 4;
            const float* sh_a = modv + 0 * 1024; const float* sc_a = modv + 1 * 1024; const float* gmix = args.in[4]; const float* dsk = args.in[15];
            for (int pair = blk * 4 + wave; pair < NB * NG; pair += G * 4) {
                const int b = pair >> 6, g = pair & 63;
                float gs[8], shv[8];
#pragma unroll
                for (int j = 0; j < 8; ++j) { const int ch = 16 * g + 8 * hi + j; gs[j] = gmix[ch] * (1.0f + sc_a[(size_t)b * MODN + ch]); shv[j] = sh_a[(size_t)b * MODN + ch]; }
                float gs4[4], sh4[4], d4[4];
#pragma unroll
                for (int j = 0; j < 4; ++j) { const int ch = 16 * g + 4 * fq + j; gs4[j] = gmix[ch] * (1.0f + sc_a[(size_t)b * MODN + ch]); sh4[j] = sh_a[(size_t)b * MODN + ch]; d4[j] = dsk[ch]; }
                bf16x8 bfrag[4], cfrag[4];
#pragma unroll
                for (int pt = 0; pt < 4; ++pt) bfrag[pt] = *(const bf16x8*)(Bop + ((size_t)(g * 128 + 32 * pt + r32) * 16 + 8 * hi));
#pragma unroll
                for (int ks = 0; ks < 4; ++ks) cfrag[ks] = *(const bf16x8*)(Cm + ((size_t)(g * 16 + fr) * 128 + 32 * ks + 8 * fq));
                const f32x2 ab = abv[g * 64 + lane];
                float s_re = 0.f, s_im = 0.f;
                const float* xb = x_in + (size_t)b * SEQ * DM + 16 * g;
                const float* rsb = rstd0 + (size_t)b * SEQ;
                f32x4 nx0 = *(const f32x4*)(xb + (size_t)r32 * DM + 8 * hi), nx1 = *(const f32x4*)(xb + (size_t)r32 * DM + 8 * hi + 4); float nrs = rsb[r32];
                for (int c = 0; c < SEQ / 32; ++c) {
                    const int t0 = 32 * c;
                    const f32x4 x0 = nx0, x1 = nx1; const float rs = nrs;
                    if (c + 1 < SEQ / 32) { const float* xp = xb + (size_t)(t0 + 32 + r32) * DM + 8 * hi; nx0 = *(const f32x4*)xp; nx1 = *(const f32x4*)(xp + 4); nrs = rsb[t0 + 32 + r32]; }
                    u32x4 up;
                    up.x = pk2(x0[0] * rs * gs[0] + shv[0], x0[1] * rs * gs[1] + shv[1]); up.y = pk2(x0[2] * rs * gs[2] + shv[2], x0[3] * rs * gs[3] + shv[3]);
                    up.z = pk2(x1[0] * rs * gs[4] + shv[4], x1[1] * rs * gs[5] + shv[5]); up.w = pk2(x1[2] * rs * gs[6] + shv[6], x1[3] * rs * gs[7] + shv[7]);
                    const bf16x8 ua = __builtin_bit_cast(bf16x8, up);
#pragma unroll
                    for (int pt = 0; pt < 4; ++pt) {
                        f32x16 z = {0.f, 0.f, 0.f, 0.f, 0.f, 0.f, 0.f, 0.f, 0.f, 0.f, 0.f, 0.f, 0.f, 0.f, 0.f, 0.f};
                        z = __builtin_amdgcn_mfma_f32_32x32x16_bf16(ua, bfrag[pt], z, 0, 0, 0);
#pragma unroll
                        for (int i = 0; i < 16; ++i) BUl[((i & 3) + 8 * (i >> 2) + 4 * hi) * 128 + 32 * pt + r32] = z[i];
                    }
                    LDS_WAIT();
#pragma unroll
                    for (int t = 0; t < 32; ++t) {
                        const f32x2 bu = *(const LAS f32x2*)(BUl + t * 128 + 2 * lane);
                        const float nr = ab[0] * s_re - ab[1] * s_im + bu[0];
                        const float ni = ab[0] * s_im + ab[1] * s_re + bu[1];
                        s_re = nr; s_im = ni;
                        Sl[t * 64 + lane] = pk2(s_re, s_im);
                    }
                    LDS_WAIT();
#pragma unroll
                    for (int nt = 0; nt < 2; ++nt) {
                        f32x4 acc = {0.f, 0.f, 0.f, 0.f};
#pragma unroll
                        for (int ks = 0; ks < 4; ++ks) { const bf16x8 sf = *(const LAS bf16x8*)((const LAS unsigned char*)Sl + (16 * nt + fr) * 256 + 64 * ks + 16 * fq);
                            acc = __builtin_amdgcn_mfma_f32_16x16x32_bf16(cfrag[ks], sf, acc, 0, 0, 0); }
                        const int t = t0 + 16 * nt + fr;
                        const f32x4 xv = *(const f32x4*)(xb + (size_t)t * DM + 4 * fq); const float rs2 = rsb[t];
                        float yo[4];
#pragma unroll
                        for (int j = 0; j < 4; ++j) { const float u = xv[j] * rs2 * gs4[j] + sh4[j]; const float y = acc[j] + d4[j] * u;
                            const float kk = 0.7978845608028654f * (y + 0.044715f * y * y * y);
                            yo[j] = y * __builtin_amdgcn_rcpf(1.0f + __builtin_amdgcn_exp2f(-2.0f * 1.4426950408889634f * kk)); }
                        u32x2 o2; o2.x = pk2(yo[0], yo[1]); o2.y = pk2(yo[2], yo[3]);
                        *(u32x2*)(Yg + ((size_t)(b * SEQ + t) * DM + 16 * g + 4 * fq)) = o2;
                    }
                    LDS_WAIT();
                }
            }
        }
    }
    SEAM(1);

    if (IN(2)) {
        pg8::Gemm g{Yg, Wglu, MTOK, 2 * DM, DM}; pg8::StaticOrder S; S.init(MTOK, 2 * DM, G, blk);
        pg8::EpiGlu E{x_in, X, modv + 2 * 1024};
        pg8::gemm_phase<pg8::EpiGlu>(lds, g, S, E);
    }
    SEAM(2);

#define NORM_ROW(Gv, SH, SC, OUT) do { \
        _Pragma("unroll") for (int j = 0; j < 4; ++j) { const int col = 4 * lane + 256 * j; \
            const f32x4 gg = *(const f32x4*)((Gv) + col), s4 = *(const f32x4*)((SC) + (size_t)b * MODN + col), t4 = *(const f32x4*)((SH) + (size_t)b * MODN + col); \
            const f32x4 o = v[j] * rs * gg * (1.0f + s4) + t4; u32x2 w; w.x = pk2(o[0], o[1]); w.y = pk2(o[2], o[3]); \
            *(u32x2*)((OUT) + (size_t)row * DM + col) = w; } } while (0)
#define NORM_PHASE(BODY) do { for (int row = gw; row < MTOK; row += NGW) { const int b = row >> 11; \
        const f32x4* xr = (const f32x4*)(X + (size_t)row * DM) + lane; f32x4 v[4]; float ss = 0.f; \
        _Pragma("unroll") for (int j = 0; j < 4; ++j) { v[j] = xr[64 * j]; ss += (v[j][0] * v[j][0] + v[j][1] * v[j][1]) + (v[j][2] * v[j][2] + v[j][3] * v[j][3]); } \
        const float rs = 1.0f / sqrtf(wave_sum(ss) * (1.0f / DM) + EPS); BODY } } while (0)

    if (IN(3)) { NORM_PHASE( NORM_ROW(args.in[5], modv + 3 * 1024, modv + 4 * 1024, Hb); ); }
    SEAM(3);
    if (IN(4)) {
        pg8::Gemm g{Hb, W1t, MTOK, FFD, DM}; pg8::StaticOrder S; S.init(MTOK, FFD, G, blk);
        pg8::EpiRelu2 E{Fb, FFD};
        pg8::gemm_phase<pg8::EpiRelu2>(lds, g, S, E);
    }
    SEAM(4);
    if (IN(5)) {
        pg8::Gemm g{Fb, W2t, MTOK, DM, FFD}; pg8::StaticOrder S; S.init(MTOK, DM, G, blk);
        pg8::EpiRes E{X, modv + 5 * 1024};
        pg8::gemm_phase<pg8::EpiRes>(lds, g, S, E);
    }
    SEAM(5);
    if (IN(6)) { NORM_PHASE( NORM_ROW(args.in[19], modv + 12288, modv + 13312, Hb); NORM_ROW(args.in[4] + DM, modv + 6144, modv + 6144 + 1024, Yg); ); }
    SEAM(6);
    if (IN(7)) {
#ifndef P7_NO_KV
        { pg8::Gemm g{Hb, Wkv, MTOK, 2 * DM, DM}; pg8::StaticOrder S; S.init(MTOK, 2 * DM, G, blk);
          pg8::EpiHeads<0> E{Kb, VT, args.in[21]};
          pg8::gemm_phase<pg8::EpiHeads<0>>(lds, g, S, E); }
#endif
#ifndef P7_NO_Q
        { pg8::Gemm g{Yg, Wq, MTOK, DM, DM}; pg8::StaticOrder S; S.init(MTOK, DM, G, blk);
          pg8::EpiHeads<1> E{Qb, nullptr, args.in[23]};
          pg8::gemm_phase<pg8::EpiHeads<1>>(lds, g, S, E); }
#endif
    }
    SEAM(7);

    if (IN(8)) {
        const int r32 = lane & 31, hi = lane >> 5;
        const int kperm = 16 * ((r32 >> 2) & 1) + 4 * (r32 >> 3) + (r32 & 3);
        for (int u = blk; u < NB * NHEAD * 4; u += G) {
            const int rr = u >> 8, bl = u & 255, xcd = bl & 7, cc = bl >> 3;
            const int bh = xcd * 32 + 8 * rr + (cc >> 2), qb = (cc + rr) & 3;
            const int qtA = 16 * qb + wave, qtB = 16 * qb + 15 - wave;
            const bf16_t* Qh = Qb + (size_t)bh * SEQ * HD; const bf16_t* Kh = Kb + (size_t)bh * SEQ * HD; const bf16_t* Vh = VT + (size_t)bh * HD * SEQ;
            bf16x8 qA[4], qB[4];
#pragma unroll
            for (int d0 = 0; d0 < 4; ++d0) { qA[d0] = *(const bf16x8*)(Qh + (size_t)(32 * qtA + r32) * HD + 16 * d0 + 8 * hi); qB[d0] = *(const bf16x8*)(Qh + (size_t)(32 * qtB + r32) * HD + 16 * d0 + 8 * hi); }
            f32x16 oA0, oA1, oB0, oB1;
#pragma unroll
            for (int i = 0; i < 16; ++i) { oA0[i] = 0.f; oA1[i] = 0.f; oB0[i] = 0.f; oB1[i] = 0.f; }
            float carA = 1.f, carB = 1.f;
#define ATT_TILE(QF, O0, O1, CAR, DIAG) do { \
                f32x16 s_ = {0.f, 0.f, 0.f, 0.f, 0.f, 0.f, 0.f, 0.f, 0.f, 0.f, 0.f, 0.f, 0.f, 0.f, 0.f, 0.f}; \
                _Pragma("unroll") for (int d0 = 0; d0 < 4; ++d0) s_ = __builtin_amdgcn_mfma_f32_32x32x16_bf16(kf[d0], QF[d0], s_, 0, 0, 0); \
                float be_[16], fl_[16]; \
                _Pragma("unroll") for (int i = 0; i < 16; ++i) { const float e_ = __builtin_amdgcn_exp2f(-s_[i]); const float r_ = __builtin_amdgcn_rcpf(1.0f + e_); be_[i] = r_; fl_[i] = e_ * r_; \
                    if (DIAG) { if (16 * hi + i >= r32) { be_[i] = 0.f; fl_[i] = 1.f; } } } \
                float T_ = ((fl_[0] * fl_[1]) * (fl_[2] * fl_[3])) * ((fl_[4] * fl_[5]) * (fl_[6] * fl_[7])); \
                T_ *= ((fl_[8] * fl_[9]) * (fl_[10] * fl_[11])) * ((fl_[12] * fl_[13]) * (fl_[14] * fl_[15])); \
                const float Tp_ = __shfl_xor(T_, 32); \
                float run_ = CAR * (hi ? 1.0f : Tp_); \
                _Pragma("unroll") for (int i = 15; i >= 0; --i) { be_[i] *= run_; run_ *= fl_[i]; } \
                CAR *= T_ * Tp_; \
                u32x4 p0_, p1_; \
                p0_.x = pk2(be_[0], be_[1]); p0_.y = pk2(be_[2], be_[3]); p0_.z = pk2(be_[4], be_[5]); p0_.w = pk2(be_[6], be_[7]); \
                p1_.x = pk2(be_[8], be_[9]); p1_.y = pk2(be_[10], be_[11]); p1_.z = pk2(be_[12], be_[13]); p1_.w = pk2(be_[14], be_[15]); \
                const bf16x8 w0_ = __builtin_bit_cast(bf16x8, p0_), w1_ = __builtin_bit_cast(bf16x8, p1_); \
                O0 = __builtin_amdgcn_mfma_f32_32x32x16_bf16(vf[0][0], w0_, O0, 0, 0, 0); O0 = __builtin_amdgcn_mfma_f32_32x32x16_bf16(vf[0][1], w1_, O0, 0, 0, 0); \
                O1 = __builtin_amdgcn_mfma_f32_32x32x16_bf16(vf[1][0], w0_, O1, 0, 0, 0); O1 = __builtin_amdgcn_mfma_f32_32x32x16_bf16(vf[1][1], w1_, O1, 0, 0, 0); \
            } while (0)
            for (int kt = qtB; kt >= 0; --kt) {
                bf16x8 kf[4], vf[2][2];
#pragma unroll
                for (int d0 = 0; d0 < 4; ++d0) kf[d0] = *(const bf16x8*)(Kh + (size_t)(32 * kt + kperm) * HD + 16 * d0 + 8 * hi);
#pragma unroll
                for (int dt = 0; dt < 2; ++dt)
#pragma unroll
                    for (int ks = 0; ks < 2; ++ks) vf[dt][ks] = *(const bf16x8*)(Vh + (size_t)(32 * dt + r32) * SEQ + 32 * kt + 16 * hi + 8 * ks);
                if (kt == qtB) ATT_TILE(qB, oB0, oB1, carB, true); else ATT_TILE(qB, oB0, oB1, carB, false);
                if (kt <= qtA) { if (kt == qtA) ATT_TILE(qA, oA0, oA1, carA, true); else ATT_TILE(qA, oA0, oA1, carA, false); }
            }
#undef ATT_TILE
            const int b = bh >> 4, h = bh & 15;
#define ATT_STORE(QT, O0, O1) do { bf16_t* op = Ob + ((size_t)(b * SEQ + 32 * (QT) + r32) * DM + h * HD + 4 * hi); \
                _Pragma("unroll") for (int i4 = 0; i4 < 4; ++i4) { u32x2 w; w.x = pk2(O0[4 * i4], O0[4 * i4 + 1]); w.y = pk2(O0[4 * i4 + 2], O0[4 * i4 + 3]); *(u32x2*)(op + 8 * i4) = w; \
                    u32x2 w2; w2.x = pk2(O1[4 * i4], O1[4 * i4 + 1]); w2.y = pk2(O1[4 * i4 + 2], O1[4 * i4 + 3]); *(u32x2*)(op + 32 + 8 * i4) = w2; } } while (0)
            ATT_STORE(qtA, oA0, oA1); ATT_STORE(qtB, oB0, oB1);
#undef ATT_STORE
        }
    }
    SEAM(8);
    if (IN(9)) {
        pg8::Gemm g{Ob, Wo, MTOK, DM, DM}; pg8::StaticOrder S; S.init(MTOK, DM, G, blk);
        pg8::EpiRes E{X, modv + 6144 + 2 * 1024};
        pg8::gemm_phase<pg8::EpiRes>(lds, g, S, E);
    }
    SEAM(9);
    if (IN(10)) { NORM_PHASE( NORM_ROW(args.in[5] + DM, modv + 6144 + 3 * 1024, modv + 6144 + 4 * 1024, Hb); ); }
    SEAM(10);
    if (IN(11)) {
        pg8::Gemm g{Hb, W1t + (size_t)DM * FFD, MTOK, FFD, DM}; pg8::StaticOrder S; S.init(MTOK, FFD, G, blk);
        pg8::EpiRelu2 E{Fb, FFD};
        pg8::gemm_phase<pg8::EpiRelu2>(lds, g, S, E);
    }
    SEAM(11);
    if (IN(12)) {
        pg8::Gemm g{Fb, W2t + (size_t)DM * FFD, MTOK, DM, FFD}; pg8::StaticOrder S; S.init(MTOK, DM, G, blk);
        pg8::EpiRes E{X, modv + 6144 + 5 * 1024};
        pg8::gemm_phase<pg8::EpiRes>(lds, g, S, E);
    }
#undef IN
#undef SEAM
}

extern "C" void kernel_launch(void* const* d_in, const int* in_sizes, int n_in, void* d_out, int out_size, void* d_ws, size_t ws_size, hipStream_t stream) {
    static int grid = 0;
    if (grid == 0) {
        if (n_in != 25 || out_size != MTOK * DM || ws_size < WS_END) { fprintf(stderr, "kernel_launch: unexpected shapes (n_in %d, out %d, ws %zu)\n", n_in, out_size, ws_size); grid = -1; return; }
        int dev = 0, cus = 0, per_cu = 0;
        hipGetDevice(&dev); hipDeviceGetAttribute(&cus, hipDeviceAttributeMultiprocessorCount, dev);
        if (hipFuncSetAttribute((const void*)yoco_fwd, hipFuncAttributeMaxDynamicSharedMemorySize, LDS_BYTES) != hipSuccess) { fprintf(stderr, "kernel_launch: hipFuncSetAttribute failed\n"); grid = -1; return; }
        if (hipOccupancyMaxActiveBlocksPerMultiprocessor(&per_cu, (const void*)yoco_fwd, NTHREADS, LDS_BYTES) != hipSuccess || per_cu < 1) { fprintf(stderr, "kernel_launch: occupancy query says %d\n", per_cu); per_cu = 1; }
        (void)hipGetLastError();
        grid = cus * 1;
        if (grid <= 0) grid = 256;
    }
    if (grid < 0) return;
    Args a{};
    for (int i = 0; i < 25; ++i) a.in[i] = (const float*)d_in[i];
    a.out = (float*)d_out; a.ws = (unsigned char*)d_ws; a.ph_lo = 0; a.ph_hi = 13;
    void* kargs[] = {&a};
    hipError_t e = hipLaunchCooperativeKernel((const void*)yoco_fwd, dim3(grid), dim3(NTHREADS), kargs, LDS_BYTES, stream);
    if (e != hipSuccess) fprintf(stderr, "cooperative launch failed: %s (grid %d)\n", hipGetErrorString(e), grid);
}
```

```cpp
#include <hip/hip_runtime.h>
#include <hip/hip_cooperative_groups.h>
#include <cstdio>
#include <cstdint>
namespace cg = cooperative_groups;

#define LAS __attribute__((address_space(3)))
#define DI __device__ __forceinline__
typedef unsigned short bf16_t;
typedef short bf16x8 __attribute__((ext_vector_type(8)));
typedef float f32x2 __attribute__((ext_vector_type(2)));
typedef float f32x4 __attribute__((ext_vector_type(4)));
typedef float f32x16 __attribute__((ext_vector_type(16)));
typedef unsigned u32x2 __attribute__((ext_vector_type(2)));
typedef unsigned u32x4 __attribute__((ext_vector_type(4)));
typedef __bf16 bf16x2_t __attribute__((ext_vector_type(2)));

constexpr int NB = 16, SEQ = 2048, DM = 1024, MTOK = NB * SEQ, FFD = 4096, NG = 64, NP = 64, NHEAD = 16, HD = 64;
constexpr int MODN = 14336;
constexpr float EPS = 1e-6f;
constexpr float QSCALE = 0.125f * 1.4426950408889634f;
constexpr int NWAVES = 8, NTHREADS = 512;
constexpr int LDS_BYTES = 135168;

constexpr size_t MiB = 1u << 20;
constexpr size_t WS_WGLU = 0, WS_W1 = 4 * MiB, WS_W2 = 20 * MiB, WS_WKV = 36 * MiB, WS_WQ = 40 * MiB, WS_WO = 42 * MiB;
constexpr size_t WS_MOD = 44 * MiB, WS_RSTD = 45 * MiB, WS_AB = 45 * MiB + 256 * 1024, WS_BOP = 45 * MiB + 512 * 1024, WS_CM = 45 * MiB + 768 * 1024;
constexpr size_t WS_YG = 48 * MiB, WS_H = 112 * MiB, WS_F = 176 * MiB;
constexpr size_t WS_Q = 176 * MiB, WS_K = 240 * MiB, WS_VT = 304 * MiB, WS_O = 368 * MiB, WS_CTL = 432 * MiB, CTL_BYTES = 16384, WS_END = 433 * MiB;

DI unsigned pk2(float lo, float hi) { f32x2 v = {lo, hi}; bf16x2_t b = __builtin_convertvector(v, bf16x2_t); return __builtin_bit_cast(unsigned, b); }
DI float wave_sum(float v) {
#pragma unroll
    for (int o = 1; o < 64; o <<= 1) v += __shfl_xor(v, o);
    return v;
}
#define LDS_WAIT() asm volatile("s_waitcnt lgkmcnt(0)" ::: "memory")

namespace pg8 {
constexpr int BM = 256, BK = 64, HALF = 128, HTB = HALF * BK * 2, STAGE_BYTES = 8 * HTB, NXCD = 8, WGM = 8;
__host__ __device__ __forceinline__ int lds_byte(int r, int c) { const int st = (r >> 4) * 2 + (c >> 5), rr = r & 15, cc = c & 31, ob = rr * 64 + cc * 2; return st * 1024 + (ob ^ (((ob >> 9) & 1) << 5)); }
__host__ __device__ __forceinline__ void stage_rc(int b, int& R, int& C) { const int st = b / 1024, sb = b % 1024, swz = sb ^ (((sb >> 9) & 1) << 5); R = (st >> 1) * 16 + swz / 64; C = (st & 1) * 32 + (swz % 64) / 2; }
__host__ __device__ __forceinline__ int perm32(int rho) { const int n = rho >> 4, i = rho & 15; return 8 * (i >> 2) + 4 * n + (i & 3); }
struct Unit { int pm, pn; };
struct Gemm { const bf16_t* A; const bf16_t* Bt; int M, N, K; };
struct StaticOrder {
    int nM, nN, nwg, G, c;
    __device__ void init(int M, int N, int G_, int c_) { nM = M / BM; nN = N / BM; nwg = nM * nN; G = G_; c = c_; }
    __device__ bool next(int i, Unit& u) const {
        const long L = (long)i * G + c; if (L >= nwg) return false;
        int wgid = (int)L; { const int q = nwg / NXCD, r = nwg % NXCD, xcd = wgid % NXCD, off = wgid / NXCD; wgid = (xcd < r ? xcd * (q + 1) : r * (q + 1) + (xcd - r) * q) + off; }
        const int nig = WGM * nN, gid = wgid / nig, fm = gid * WGM, gsz = (nM - fm) < WGM ? (nM - fm) : WGM;
        u.pm = fm + ((wgid % nig) % gsz); u.pn = (wgid % nig) / gsz; return true;
    }
};
template <class Epi>
__device__ __forceinline__ void gemm_phase(LAS unsigned char* lds, const Gemm g, const StaticOrder& S, const Epi& E) {
    const int tid = threadIdx.x, wid = __builtin_amdgcn_readfirstlane(tid >> 6), lane = tid & 63, wr = wid >> 2, wc = wid & 3, fr = lane & 15, fq = lane >> 4;
    const int K = g.K, nt = K / BK;
    unsigned voffA[2], voffB[2];
#pragma unroll
    for (int i = 0; i < 2; ++i) { int R, C; stage_rc(tid * 16 + i * 8192, R, C); const int Rb = Epi::PERM ? ((R & ~31) + perm32(R & 31)) : R;
        voffA[i] = (unsigned)(R * K + C) * 2u; voffB[i] = (unsigned)(Rb * K + C) * 2u; }
    const size_t kstep = (size_t)(BK * 2);
    const size_t hstep = (size_t)HALF * K * 2;
    const size_t tstep = 2 * hstep;
    const unsigned ldsw = (unsigned)wid * 1024u;
    const int aoff = lds_byte(wr * 64 + fr, fq * 8), boff = lds_byte(wc * 32 + fr, fq * 8);
#define PG8_SA(b, h) (((b) * 2 + (h)) * HTB)
#define PG8_SB(b, h) ((4 + (b) * 2 + (h)) * HTB)
#define PG8_STAGE(bufoff, gbase, voff) do { _Pragma("unroll") for (int _i = 0; _i < 2; ++_i) \
        __builtin_amdgcn_global_load_lds((const unsigned*)((const char*)(gbase) + (voff)[_i]), (LAS unsigned*)(lds + (bufoff) + ldsw + _i * 8192), 16, 0, 0); } while (0)
#define PG8_LDA(dst, b, h) do { _Pragma("unroll") for (int m = 0; m < 4; ++m) _Pragma("unroll") for (int k = 0; k < 2; ++k) dst[m][k] = *(const LAS bf16x8*)(lds + PG8_SA(b, h) + aoff + m * 2048 + k * 1024); } while (0)
#define PG8_LDB(dst, b, h) do { _Pragma("unroll") for (int n = 0; n < 2; ++n) _Pragma("unroll") for (int k = 0; k < 2; ++k) dst[n][k] = *(const LAS bf16x8*)(lds + PG8_SB(b, h) + boff + n * 2048 + k * 1024); } while (0)
#define PG8_MMA(ai, bj, At, Bt) do { __builtin_amdgcn_s_setprio(1); _Pragma("unroll") for (int m = 0; m < 4; ++m) _Pragma("unroll") for (int n = 0; n < 2; ++n) _Pragma("unroll") for (int k = 0; k < 2; ++k) \
        acc[ai][bj][m][n] = __builtin_amdgcn_mfma_f32_16x16x32_bf16(Bt[n][k], At[m][k], acc[ai][bj][m][n], 0, 0, 0); __builtin_amdgcn_s_setprio(0); } while (0)
#define PG8_WAIT_V(n) asm volatile("s_waitcnt vmcnt(" #n ")" ::: "memory")
#define PG8_WAIT_L(n) asm volatile("s_waitcnt lgkmcnt(" #n ")" ::: "memory")
#define PG8_BAR __builtin_amdgcn_s_barrier()
#define PG8_SCHED __builtin_amdgcn_sched_barrier(0)
    Unit cur, nxt; int ui = 0;
    if (!S.next(0, cur)) return;
    f32x4 acc[2][2][4][2];
#pragma unroll
    for (int a = 0; a < 2; ++a)
#pragma unroll
        for (int b = 0; b < 2; ++b)
#pragma unroll
            for (int m = 0; m < 4; ++m)
#pragma unroll
                for (int n = 0; n < 2; ++n) acc[a][b][m][n] = (f32x4){0.f, 0.f, 0.f, 0.f};
    bf16x8 At[4][2], B0[2][2], B1[2][2];
    const char* cA = (const char*)g.A + (size_t)cur.pm * tstep; const char* cB = (const char*)g.Bt + (size_t)cur.pn * tstep;
    PG8_STAGE(PG8_SB(0, 0), cB, voffB); PG8_STAGE(PG8_SB(0, 1), cB + hstep, voffB); PG8_STAGE(PG8_SA(0, 0), cA, voffA); PG8_STAGE(PG8_SA(0, 1), cA + hstep, voffA);
    if (wr == 1) PG8_BAR;
    PG8_WAIT_V(2); PG8_BAR;
    PG8_STAGE(PG8_SB(1, 0), cB + kstep, voffB); PG8_STAGE(PG8_SA(1, 0), cA + kstep, voffA); PG8_STAGE(PG8_SB(1, 1), cB + hstep + kstep, voffB);
    PG8_WAIT_V(6); PG8_BAR;
    for (;;) {
        const bool has_next = S.next(ui + 1, nxt);
        const char* nA = has_next ? (const char*)g.A + (size_t)nxt.pm * tstep : cA; const char* nB = has_next ? (const char*)g.Bt + (size_t)nxt.pn * tstep : cB;
        for (int t = 0; t < nt; t += 2) {
            const bool last = (t == nt - 2);
            const char* a1 = cA + (size_t)(t + 1) * kstep;
            const char* a2 = last ? nA : cA + (size_t)(t + 2) * kstep; const char* b2 = last ? nB : cB + (size_t)(t + 2) * kstep;
            const char* a3 = a2 + kstep; const char* b3 = b2 + kstep;
            PG8_LDB(B0, 0, 0); PG8_LDB(B1, 0, 1); PG8_SCHED; PG8_LDA(At, 0, 0); PG8_STAGE(PG8_SA(1, 1), a1 + hstep, voffA);
            PG8_WAIT_V(8); PG8_WAIT_L(0); PG8_BAR; PG8_MMA(0, 0, At, B0); PG8_MMA(0, 1, At, B1); PG8_BAR; PG8_SCHED;
            PG8_LDA(At, 0, 1); PG8_STAGE(PG8_SB(0, 0), b2, voffB); PG8_STAGE(PG8_SB(0, 1), b2 + hstep, voffB); PG8_STAGE(PG8_SA(0, 0), a2, voffA);
            PG8_WAIT_V(8); PG8_WAIT_L(0); PG8_BAR; PG8_MMA(1, 0, At, B0); PG8_MMA(1, 1, At, B1); PG8_BAR; PG8_SCHED;
            PG8_LDB(B0, 1, 0); PG8_LDB(B1, 1, 1); PG8_SCHED; PG8_LDA(At, 1, 0); PG8_STAGE(PG8_SA(0, 1), a2 + hstep, voffA);
            PG8_WAIT_V(8); PG8_WAIT_L(0); PG8_BAR; PG8_MMA(0, 0, At, B0); PG8_MMA(0, 1, At, B1); PG8_BAR; PG8_SCHED;
            PG8_LDA(At, 1, 1); PG8_STAGE(PG8_SB(1, 0), b3, voffB); PG8_STAGE(PG8_SB(1, 1), b3 + hstep, voffB); PG8_STAGE(PG8_SA(1, 0), a3, voffA);
            PG8_WAIT_V(8); PG8_WAIT_L(0); PG8_BAR; PG8_MMA(1, 0, At, B0); PG8_MMA(1, 1, At, B1); PG8_BAR; PG8_SCHED;
        }
        if (wr == 0) PG8_BAR;
        E(acc, cur, wr, wc, fr, fq);
        if (!has_next) break;
#pragma unroll
        for (int a = 0; a < 2; ++a)
#pragma unroll
            for (int b = 0; b < 2; ++b)
#pragma unroll
                for (int m = 0; m < 4; ++m)
#pragma unroll
                    for (int n = 0; n < 2; ++n) acc[a][b][m][n] = (f32x4){0.f, 0.f, 0.f, 0.f};
        cur = nxt; cA = nA; cB = nB; ++ui;
        if (wr == 1) PG8_BAR;
    }
    PG8_WAIT_V(0);
    PG8_BAR;
#undef PG8_SA
#undef PG8_SB
#undef PG8_STAGE
#undef PG8_LDA
#undef PG8_LDB
#undef PG8_MMA
#undef PG8_WAIT_V
#undef PG8_WAIT_L
#undef PG8_BAR
#undef PG8_SCHED
}

DI float sigmoidf_(float v) { return __builtin_amdgcn_rcpf(1.0f + __builtin_amdgcn_exp2f(-1.4426950408889634f * v)); }

struct EpiGlu {
    static constexpr bool PERM = false;
    const float* x; float* out; const float* ga;
    DI void operator()(const f32x4 (&acc)[2][2][4][2], const Unit& u, int wr, int wc, int fr, int fq) const {
        const int row0 = u.pm * BM + wr * 64 + fr, b = (u.pm * BM) >> 11, col0 = u.pn * 128 + wc * 32 + 4 * fq;
        f32x4 gv[2];
#pragma unroll
        for (int n = 0; n < 2; ++n) gv[n] = *(const f32x4*)(ga + (size_t)b * MODN + col0 + 16 * n);
#pragma unroll
        for (int ai = 0; ai < 2; ++ai)
#pragma unroll
            for (int m = 0; m < 4; ++m) { const size_t ro = (size_t)(row0 + ai * HALF + m * 16) * DM + col0;
#pragma unroll
                for (int n = 0; n < 2; ++n) { const f32x4 xin = *(const f32x4*)(x + ro + 16 * n); const f32x4 v = acc[ai][0][m][n], gt = acc[ai][1][m][n]; f32x4 o;
#pragma unroll
                    for (int j = 0; j < 4; ++j) o[j] = xin[j] + gv[n][j] * v[j] * sigmoidf_(gt[j]);
                    *(f32x4*)(out + ro + 16 * n) = o; } }
    }
};
struct EpiRelu2 {
    static constexpr bool PERM = true;
    bf16_t* O; int ldc;
    DI void operator()(const f32x4 (&acc)[2][2][4][2], const Unit& u, int wr, int wc, int fr, int fq) const {
        const int row0 = u.pm * BM + wr * 64 + fr, col0 = u.pn * BM + wc * 32 + 8 * fq;
#pragma unroll
        for (int ai = 0; ai < 2; ++ai)
#pragma unroll
            for (int m = 0; m < 4; ++m) { bf16_t* rowp = O + (size_t)(row0 + ai * HALF + m * 16) * ldc + col0;
#pragma unroll
                for (int bj = 0; bj < 2; ++bj) { f32x4 v0 = acc[ai][bj][m][0], v1 = acc[ai][bj][m][1];
#pragma unroll
                    for (int j = 0; j < 4; ++j) { const float a = fmaxf(v0[j], 0.f), c = fmaxf(v1[j], 0.f); v0[j] = a * a; v1[j] = c * c; }
                    u32x4 w; w.x = pk2(v0[0], v0[1]); w.y = pk2(v0[2], v0[3]); w.z = pk2(v1[0], v1[1]); w.w = pk2(v1[2], v1[3]);
                    *(u32x4*)(rowp + bj * HALF) = w; } }
    }
};
struct EpiRes {
    static constexpr bool PERM = false;
    float* io; const float* gate;
    DI void operator()(const f32x4 (&acc)[2][2][4][2], const Unit& u, int wr, int wc, int fr, int fq) const {
        const int row0 = u.pm * BM + wr * 64 + fr, b = (u.pm * BM) >> 11, col0 = u.pn * BM + wc * 32 + 4 * fq;
        f32x4 gv[2][2];
#pragma unroll
        for (int bj = 0; bj < 2; ++bj)
#pragma unroll
            for (int n = 0; n < 2; ++n) gv[bj][n] = *(const f32x4*)(gate + (size_t)b * MODN + col0 + bj * HALF + 16 * n);
#pragma unroll
        for (int ai = 0; ai < 2; ++ai)
#pragma unroll
            for (int m = 0; m < 4; ++m) { float* rp = io + (size_t)(row0 + ai * HALF + m * 16) * DM + col0;
#pragma unroll
                for (int bj = 0; bj < 2; ++bj)
#pragma unroll
                    for (int n = 0; n < 2; ++n) { const f32x4 bs = *(const f32x4*)(rp + bj * HALF + 16 * n); *(f32x4*)(rp + bj * HALF + 16 * n) = bs + gv[bj][n] * acc[ai][bj][m][n]; } }
    }
};
template <int MODE> struct EpiHeads {
    static constexpr bool PERM = true;
    bf16_t* Kb; bf16_t* VT; const float* ng;
    DI void operator()(const f32x4 (&acc)[2][2][4][2], const Unit& u, int wr, int wc, int fr, int fq) const {
        const int b = (u.pm * BM) >> 11, s0 = ((u.pm * BM) & (SEQ - 1)) + wr * 64 + fr;
        const bool isV = (MODE == 0) && (u.pn >= 4);
        const int h = 4 * (u.pn & 3) + wc;
        if (!isV) {
            const float gsc = (MODE == 1) ? QSCALE : 1.0f;
#pragma unroll
            for (int ai = 0; ai < 2; ++ai)
#pragma unroll
                for (int m = 0; m < 4; ++m) { float ss = 0.f;
#pragma unroll
                    for (int bj = 0; bj < 2; ++bj)
#pragma unroll
                        for (int n = 0; n < 2; ++n) { const f32x4 v = acc[ai][bj][m][n]; ss += (v[0] * v[0] + v[1] * v[1]) + (v[2] * v[2] + v[3] * v[3]); }
                    ss += __shfl_xor(ss, 16); ss += __shfl_xor(ss, 32);
                    const float rs = __builtin_amdgcn_rsqf(ss * (1.0f / 64.0f) + EPS) * gsc;
                    bf16_t* rp = Kb + ((size_t)(b * NHEAD + h) * SEQ + (s0 + ai * HALF + m * 16)) * HD + 8 * fq;
#pragma unroll
                    for (int bj = 0; bj < 2; ++bj) { const f32x4 g0 = *(const f32x4*)(ng + 32 * bj + 8 * fq), g1 = *(const f32x4*)(ng + 32 * bj + 8 * fq + 4);
                        const f32x4 v0 = acc[ai][bj][m][0] * rs * g0, v1 = acc[ai][bj][m][1] * rs * g1;
                        u32x4 w; w.x = pk2(v0[0], v0[1]); w.y = pk2(v0[2], v0[3]); w.z = pk2(v1[0], v1[1]); w.w = pk2(v1[2], v1[3]);
                        *(u32x4*)(rp + 32 * bj) = w; }
                    asm volatile("" ::: "memory"); }
        } else {
            const unsigned loff = (unsigned)(8 * fq * SEQ + fr);
            bf16_t* ub = VT + (size_t)(b * NHEAD + h) * HD * SEQ + (((u.pm * BM) & (SEQ - 1)) + wr * 64);
#pragma unroll
            for (int ai = 0; ai < 2; ++ai)
#pragma unroll
                for (int m = 0; m < 4; ++m) {
#pragma unroll
                    for (int bj = 0; bj < 2; ++bj)
#pragma unroll
                        for (int n = 0; n < 2; ++n) { const f32x4 v = acc[ai][bj][m][n];
#pragma unroll
                            for (int j = 0; j < 4; ++j) { bf16_t* up = ub + (size_t)(32 * bj + 4 * n + j) * SEQ + (ai * HALF + m * 16); up[loff] = (bf16_t)(pk2(v[j], 0.f) & 0xffffu); } }
                    asm volatile("" ::: "memory"); }
        }
    }
};
}

DI double dexp(double x) {
    const double n = __builtin_rint(x * 1.4426950408889634);
    double r = __builtin_fma(-n, 0.6931471805599453, x); r = __builtin_fma(-n, 2.3190468138462996e-17, r);
    double p = 1.0 / 6227020800.0;
    p = p * r + 1.0 / 479001600.0; p = p * r + 1.0 / 39916800.0; p = p * r + 1.0 / 3628800.0; p = p * r + 1.0 / 362880.0; p = p * r + 1.0 / 40320.0;
    p = p * r + 1.0 / 5040.0; p = p * r + 1.0 / 720.0; p = p * r + 1.0 / 120.0; p = p * r + 1.0 / 24.0; p = p * r + 1.0 / 6.0; p = p * r + 0.5; p = p * r + 1.0; p = p * r + 1.0;
    return __builtin_ldexp(p, (int)n);
}
DI void dsincos(double a, double& s, double& c) {
    const double q = __builtin_rint(a * 0.6366197723675814);
    double r = __builtin_fma(-q, 1.5707963267948966, a); r = __builtin_fma(-q, 6.123233995736766e-17, r);
    const int qi = ((int)q) & 3; const double r2 = r * r;
    double sp = -1.0 / 1307674368000.0; sp = sp * r2 + 1.0 / 6227020800.0; sp = sp * r2 - 1.0 / 39916800.0; sp = sp * r2 + 1.0 / 362880.0; sp = sp * r2 - 1.0 / 5040.0; sp = sp * r2 + 1.0 / 120.0; sp = sp * r2 - 1.0 / 6.0; sp = sp * r2 + 1.0; sp = sp * r;
    double cp = 1.0 / 20922789888000.0; cp = cp * r2 - 1.0 / 87178291200.0; cp = cp * r2 + 1.0 / 479001600.0; cp = cp * r2 - 1.0 / 3628800.0; cp = cp * r2 + 1.0 / 40320.0; cp = cp * r2 - 1.0 / 720.0; cp = cp * r2 + 1.0 / 24.0; cp = cp * r2 - 0.5; cp = cp * r2 + 1.0;
    s = (qi == 0) ? sp : (qi == 1) ? cp : (qi == 2) ? -sp : -cp;
    c = (qi == 0) ? cp : (qi == 1) ? -sp : (qi == 2) ? -cp : sp;
}

DI void transpose_item(const float* __restrict__ W, int K, int N, bf16_t* __restrict__ WT, int k0, int n0, int drow0, LAS float* scr, int lane) {
#pragma unroll 8
    for (int i = 0; i < 32; ++i) { const int kk = 2 * i + (lane >> 5); scr[kk * 33 + (lane & 31)] = W[(size_t)(k0 + kk) * N + n0 + (lane & 31)]; }
    LDS_WAIT();
    const int c = lane & 7;
#pragma unroll
    for (int j = 0; j < 4; ++j) { const int n = (lane >> 3) + 8 * j; const LAS float* s = scr + (8 * c) * 33 + n;
        u32x4 o; o.x = pk2(s[0 * 33], s[1 * 33]); o.y = pk2(s[2 * 33], s[3 * 33]); o.z = pk2(s[4 * 33], s[5 * 33]); o.w = pk2(s[6 * 33], s[7 * 33]);
        *(u32x4*)(WT + (size_t)(drow0 + n) * K + k0 + 8 * c) = o; }
    LDS_WAIT();
}
DI int map_rows(int mode, int n0) {
    if (mode == 1) { const int bj = n0 >> 10, rem = n0 & 1023; return 256 * (rem >> 7) + 128 * bj + (rem & 127); }
    if (mode == 2) { const int tile = n0 >> 8, off = n0 & 255; return 256 * tile + 128 * ((off & 63) >> 5) + 32 * (off >> 6); }
    return n0;
}

#define XB_TMO      128
#define XB_XCNT(j)  (256  + 64 * (j))
#define XB_XSUB(j)  (1280 + 64 * (j))
#define XB_XGEN(j)  (2304 + 64 * (j))
#define XB_TOP      3328
#define XB_TOPGEN   3392
#define XCD_BAR_WORDS 3456
#define XB_SPIN_CAP (1u << 22)
DI unsigned xb_ld(unsigned* p)              { return __hip_atomic_load(p, __ATOMIC_RELAXED, __HIP_MEMORY_SCOPE_AGENT); }
DI unsigned xb_add(unsigned* p, unsigned v) { return __hip_atomic_fetch_add(p, v, __ATOMIC_RELAXED, __HIP_MEMORY_SCOPE_AGENT); }
DI unsigned xb_xcc_id() { return (unsigned)__builtin_amdgcn_s_getreg((3 << 11) | 20) & 0xFu; }
#define XB_SPIN(cond, bar) do { unsigned _sp = 0; while (cond) { __builtin_amdgcn_s_sleep(1); \
    if ((++_sp & 255u) == 0u) { if (xb_ld(&(bar)[XB_TMO])) break; if (_sp > XB_SPIN_CAP) { atomicAdd(&(bar)[XB_TMO], 1u); break; } } } } while (0)
struct XcdBarrier { unsigned* bar; unsigned x; volatile LAS unsigned* st; };
DI XcdBarrier xcd_barrier_post(unsigned* bar, volatile LAS unsigned* st) {
    XcdBarrier b; b.bar = bar; b.x = xb_xcc_id(); b.st = st;
    if (threadIdx.x == 0) (void)xb_add(&bar[XB_XCNT(b.x)], 1u);
    return b;
}
DI void xcd_barrier_complete(unsigned* bar, unsigned x, unsigned& nloc, unsigned& nx) {
    const unsigned G = gridDim.x * gridDim.y * gridDim.z;
    unsigned sum, cnt, mine, sp = 0u;
    for (;;) {
        sum = 0u; cnt = 0u; mine = 0u;
#pragma unroll
        for (unsigned j = 0; j < 16; ++j) { const unsigned c = xb_ld(&bar[XB_XCNT(j)]); sum += c; cnt += (c > 0u) ? 1u : 0u; mine = (j == x) ? c : mine; }
        if (sum == G) break;
        __builtin_amdgcn_s_sleep(1);
        if ((++sp & 255u) == 0u) { if (xb_ld(&bar[XB_TMO])) break; if (sp > XB_SPIN_CAP) { atomicAdd(&bar[XB_TMO], 1u); break; } }
    }
    nloc = mine > 0u ? mine : 1u; nx = cnt > 0u ? cnt : 1u;
}
DI void xcd_barrier(const XcdBarrier& b) {
    asm volatile("s_waitcnt vmcnt(0)" ::: "memory");
    __syncthreads();
    if (threadIdx.x == 0) {
        unsigned* bar = b.bar;
        __builtin_amdgcn_s_waitcnt(0);
        unsigned nloc = b.st[0], nx = b.st[1];
        if (nloc == 0u) { xcd_barrier_complete(bar, b.x, nloc, nx); b.st[0] = nloc; b.st[1] = nx; }
        const unsigned old = xb_add(&bar[XB_XSUB(b.x)], 1u);
        const unsigned gen = old / nloc;
        if (old + 1u == (gen + 1u) * nloc) {
            __builtin_amdgcn_fence(__ATOMIC_RELEASE, "agent");
            asm volatile("s_waitcnt vmcnt(0)" ::: "memory");
            const unsigned og = xb_add(&bar[XB_TOP], 1u);
            const unsigned tg = og / nx;
            if (og + 1u == (tg + 1u) * nx) xb_add(&bar[XB_TOPGEN], 1u);
            else XB_SPIN(xb_ld(&bar[XB_TOPGEN]) == tg, bar);
            __builtin_amdgcn_fence(__ATOMIC_ACQUIRE, "agent");
            xb_add(&bar[XB_XGEN(b.x)], 1u);
            asm volatile("s_waitcnt vmcnt(0)" ::: "memory");
        } else {
            XB_SPIN(xb_ld(&bar[XB_XGEN(b.x)]) == gen, bar);
            __builtin_amdgcn_fence(__ATOMIC_ACQUIRE, "agent");
            asm volatile("s_waitcnt vmcnt(0)" ::: "memory");
        }
    }
    __syncthreads();
}

struct Args { const float* in[25]; float* out; unsigned char* ws; int ph_lo, ph_hi; };

__global__ void __launch_bounds__(NTHREADS, 2) yoco_fwd(Args args) {
    extern __shared__ __attribute__((aligned(16))) unsigned char lds_raw[];
    LAS unsigned char* lds = (LAS unsigned char*)lds_raw;
    cg::grid_group grid = cg::this_grid();
    const int tid = threadIdx.x, lane = tid & 63, wave = __builtin_amdgcn_readfirstlane(tid >> 6);
    const int G = gridDim.x, blk = blockIdx.x;
    const int gw = blk * NWAVES + wave, NGW = G * NWAVES;
    unsigned char* ws = args.ws;
    const float* x_in = args.in[0];
    float* X = args.out;
    bf16_t* Wglu = (bf16_t*)(ws + WS_WGLU); bf16_t* W1t = (bf16_t*)(ws + WS_W1); bf16_t* W2t = (bf16_t*)(ws + WS_W2);
    bf16_t* Wkv = (bf16_t*)(ws + WS_WKV); bf16_t* Wq = (bf16_t*)(ws + WS_WQ); bf16_t* Wo = (bf16_t*)(ws + WS_WO);
    float* modv = (float*)(ws + WS_MOD); float* rstd0 = (float*)(ws + WS_RSTD);
    f32x2* abv = (f32x2*)(ws + WS_AB); bf16_t* Bop = (bf16_t*)(ws + WS_BOP); bf16_t* Cm = (bf16_t*)(ws + WS_CM);
    bf16_t* Yg = (bf16_t*)(ws + WS_YG); bf16_t* Hb = (bf16_t*)(ws + WS_H); bf16_t* Fb = (bf16_t*)(ws + WS_F);
    bf16_t* Qb = (bf16_t*)(ws + WS_Q); bf16_t* Kb = (bf16_t*)(ws + WS_K); bf16_t* VT = (bf16_t*)(ws + WS_VT); bf16_t* Ob = (bf16_t*)(ws + WS_O);
    const int lo = args.ph_lo, hi_ph = args.ph_hi;
#ifndef PHMASK
#define PHMASK 0x1fff
#endif
#define IN(k) (((PHMASK >> (k)) & 1) && lo <= (k) && (k) < hi_ph)
    volatile LAS unsigned* MISC = (volatile LAS unsigned*)(lds + LDS_BYTES - 256);
    if (tid < 16) MISC[tid] = 0u;
    __syncthreads();
    const XcdBarrier xbar = xcd_barrier_post((unsigned*)(ws + WS_CTL), MISC + 8);
#define SEAM(k) do { if (IN(k) && IN((k) + 1)) { if ((k) == 0) grid.sync(); else xcd_barrier(xbar); } } while (0)

    if (IN(0)) {
        {
            LAS float* sc = (LAS float*)lds;
            LAS float* red = (LAS float*)(lds + 65536);
            const float* cvec = args.in[1];
            bool have_sc = false;
            for (int cb = blk; cb < MODN / 64; cb += G) {
                if (!have_sc) {
                    for (int i = tid; i < NB * DM; i += NTHREADS) { const float v = cvec[i]; sc[(i & 1023) * 16 + (i >> 10)] = v / (1.0f + __expf(-v)); }
                    __syncthreads(); have_sc = true;
                }
                const int e = cb * 64 + lane;
                const float* Wp; int stride; const float* bias;
                if (e < 12288) { const int l = e / 6144, ee = e - l * 6144; Wp = args.in[2] + (size_t)l * DM * 6144 + ee; stride = 6144; bias = args.in[3] + l * 6144 + ee; }
                else { const int ee = e - 12288; Wp = args.in[17] + ee; stride = 2048; bias = args.in[18] + ee; }
                float a[16];
#pragma unroll
                for (int b = 0; b < 16; ++b) a[b] = 0.f;
                const int d0 = wave * 128;
#pragma unroll 4
                for (int d = 0; d < 128; ++d) { const float w = Wp[(size_t)(d0 + d) * stride];
                    const LAS f32x4* sp = (const LAS f32x4*)(sc + (d0 + d) * 16);
#pragma unroll
                    for (int q = 0; q < 4; ++q) { const f32x4 s4 = sp[q]; a[4 * q] += w * s4[0]; a[4 * q + 1] += w * s4[1]; a[4 * q + 2] += w * s4[2]; a[4 * q + 3] += w * s4[3]; } }
#pragma unroll
                for (int b = 0; b < 16; ++b) red[(wave * 16 + b) * 64 + lane] = a[b];
                __syncthreads();
                for (int o = tid; o < 1024; o += NTHREADS) { const int b = o >> 6, cl = o & 63; float s = 0.f;
#pragma unroll
                    for (int w8 = 0; w8 < 8; ++w8) s += red[(w8 * 16 + b) * 64 + cl];
                    const int ee = cb * 64 + cl; const float bs = (ee < 12288) ? args.in[3][ee] : args.in[18][ee - 12288];
                    modv[(size_t)b * MODN + ee] = s + bs; }
                __syncthreads();
                (void)bias;
            }
            __syncthreads();
        }
        for (int i = blk * NTHREADS + tid; i < NG * NP; i += G * NTHREADS) {
            const int g = i >> 6, p = i & 63;
            const double lre = (double)args.in[8][i], lim = (double)args.in[9][i], dt = dexp((double)args.in[10][g]);
            const double mag = dexp(lre * dt); double sn, cs; dsincos(lim * dt, sn, cs);
            const double are = mag * cs, aim = mag * sn, den = lre * lre + lim * lim, nr = are - 1.0, ni = aim;
            const double fre = (nr * lre + ni * lim) / den, fim = (ni * lre - nr * lim) / den;
            abv[i] = (f32x2){(float)are, (float)aim};
            const float* bre = args.in[11] + (size_t)i * 16; const float* bim = args.in[12] + (size_t)i * 16;
#pragma unroll
            for (int h = 0; h < 16; h += 2) {
                const double br0 = bre[h], bi0 = bim[h], br1 = bre[h + 1], bi1 = bim[h + 1];
                *(unsigned*)(Bop + ((size_t)(g * 128 + 2 * p) * 16 + h)) = pk2((float)(fre * br0 - fim * bi0), (float)(fre * br1 - fim * bi1));
                *(unsigned*)(Bop + ((size_t)(g * 128 + 2 * p + 1) * 16 + h)) = pk2((float)(fre * bi0 + fim * br0), (float)(fre * bi1 + fim * br1));
            }
#pragma unroll
            for (int h = 0; h < 16; ++h) {
                const float cr = args.in[13][(size_t)(g * 16 + h) * 64 + p], ci = args.in[14][(size_t)(g * 16 + h) * 64 + p];
                *(unsigned*)(Cm + ((size_t)(g * 16 + h) * 128 + 2 * p)) = pk2(cr, -ci);
            }
        }
        for (int row = gw; row < MTOK; row += NGW) {
            const f32x4* xr = (const f32x4*)(x_in + (size_t)row * DM) + lane; float ss = 0.f;
#pragma unroll
            for (int j = 0; j < 4; ++j) { const f32x4 v = xr[64 * j]; ss += (v[0] * v[0] + v[1] * v[1]) + (v[2] * v[2] + v[3] * v[3]); }
            ss = wave_sum(ss);
            if (lane == 0) rstd0[row] = 1.0f / sqrtf(ss * (1.0f / DM) + EPS);
        }
    }
    SEAM(0);

    if (IN(1)) {
        if (wave < 4) {
            LAS float* BUl = (LAS float*)(lds + wave * 24576);
            LAS unsigned* Sl = (LAS unsigned*)(lds + wave * 24576 + 16384);
            const int r32 = lane & 31, hi = lane >> 5, fr = lane & 15, fq = lane >> 4;
            const float* sh_a = modv + 0 * 1024; const float* sc_a = modv + 1 * 1024; const float* gmix = args.in[4]; const float* dsk = args.in[15];
            for (int pair = blk * 4 + wave; pair < NB * NG; pair += G * 4) {
                const int b = pair >> 6, g = pair & 63;
                float gs[8], shv[8];
#pragma unroll
                for (int j = 0; j < 8; ++j) { const int ch = 16 * g + 8 * hi + j; gs[j] = gmix[ch] * (1.0f + sc_a[(size_t)b * MODN + ch]); shv[j] = sh_a[(size_t)b * MODN + ch]; }
                float gs4[4], sh4[4], d4[4];
#pragma unroll
                for (int j = 0; j < 4; ++j) { const int ch = 16 * g + 4 * fq + j; gs4[j] = gmix[ch] * (1.0f + sc_a[(size_t)b * MODN + ch]); sh4[j] = sh_a[(size_t)b * MODN + ch]; d4[j] = dsk[ch]; }
                bf16x8 bfrag[4], cfrag[4];
#pragma unroll
                for (int pt = 0; pt < 4; ++pt) bfrag[pt] = *(const bf16x8*)(Bop + ((size_t)(g * 128 + 32 * pt + r32) * 16 + 8 * hi));
#pragma unroll
                for (int ks = 0; ks < 4; ++ks) cfrag[ks] = *(const bf16x8*)(Cm + ((size_t)(g * 16 + fr) * 128 + 32 * ks + 8 * fq));
                const f32x2 ab = abv[g * 64 + lane];
                float s_re = 0.f, s_im = 0.f;
                const float* xb = x_in + (size_t)b * SEQ * DM + 16 * g;
                const float* rsb = rstd0 + (size_t)b * SEQ;
                f32x4 nx0 = *(const f32x4*)(xb + (size_t)r32 * DM + 8 * hi), nx1 = *(const f32x4*)(xb + (size_t)r32 * DM + 8 * hi + 4); float nrs = rsb[r32];
                for (int c = 0; c < SEQ / 32; ++c) {
                    const int t0 = 32 * c;
                    const f32x4 x0 = nx0, x1 = nx1; const float rs = nrs;
                    if (c + 1 < SEQ / 32) { const float* xp = xb + (size_t)(t0 + 32 + r32) * DM + 8 * hi; nx0 = *(const f32x4*)xp; nx1 = *(const f32x4*)(xp + 4); nrs = rsb[t0 + 32 + r32]; }
                    u32x4 up;
                    up.x = pk2(x0[0] * rs * gs[0] + shv[0], x0[1] * rs * gs[1] + shv[1]); up.y = pk2(x0[2] * rs * gs[2] + shv[2], x0[3] * rs * gs[3] + shv[3]);
                    up.z = pk2(x1[0] * rs * gs[4] + shv[4], x1[1] * rs * gs[5] + shv[5]); up.w = pk2(x1[2] * rs * gs[6] + shv[6], x1[3] * rs * gs[7] + shv[7]);
                    const bf16x8 ua = __builtin_bit_cast(bf16x8, up);
#pragma unroll
                    for (int pt = 0; pt < 4; ++pt) {
                        f32x16 z = {0.f, 0.f, 0.f, 0.f, 0.f, 0.f, 0.f, 0.f, 0.f, 0.f, 0.f, 0.f, 0.f, 0.f, 0.f, 0.f};
                        z = __builtin_amdgcn_mfma_f32_32x32x16_bf16(ua, bfrag[pt], z, 0, 0, 0);
#pragma unroll
                        for (int i = 0; i < 16; ++i) BUl[((i & 3) + 8 * (i >> 2) + 4 * hi) * 128 + 32 * pt + r32] = z[i];
                    }
                    LDS_WAIT();
#pragma unroll
                    for (int t = 0; t < 32; ++t) {
                        const f32x2 bu = *(const LAS f32x2*)(BUl + t * 128 + 2 * lane);
                        const float nr = ab[0] * s_re - ab[1] * s_im + bu[0];
                        const float ni = ab[0] * s_im + ab[1] * s_re + bu[1];
                        s_re = nr; s_im = ni;
                        Sl[t * 64 + lane] = pk2(s_re, s_im);
                    }
                    LDS_WAIT();
#pragma unroll
                    for (int nt = 0; nt < 2; ++nt) {
                        f32x4 acc = {0.f, 0.f, 0.f, 0.f};
#pragma unroll
                        for (int ks = 0; ks < 4; ++ks) { const bf16x8 sf = *(const LAS bf16x8*)((const LAS unsigned char*)Sl + (16 * nt + fr) * 256 + 64 * ks + 16 * fq);
                            acc = __builtin_amdgcn_mfma_f32_16x16x32_bf16(cfrag[ks], sf, acc, 0, 0, 0); }
                        const int t = t0 + 16 * nt + fr;
                        const f32x4 xv = *(const f32x4*)(xb + (size_t)t * DM + 4 * fq); const float rs2 = rsb[t];
                        float yo[4];
#pragma unroll
                        for (int j = 0; j < 4; ++j) { const float u = xv[j] * rs2 * gs4[j] + sh4[j]; const float y = acc[j] + d4[j] * u;
                            const float kk = 0.7978845608028654f * (y + 0.044715f * y * y * y);
                            yo[j] = y * __builtin_amdgcn_rcpf(1.0f + __builtin_amdgcn_exp2f(-2.0f * 1.4426950408889634f * kk)); }
                        u32x2 o2; o2.x = pk2(yo[0], yo[1]); o2.y = pk2(yo[2], yo[3]);
                        *(u32x2*)(Yg + ((size_t)(b * SEQ + t) * DM + 16 * g + 4 * fq)) = o2;
                    }
                    LDS_WAIT();
                }
            }
        } else {
        {
            LAS float* scr = (LAS float*)(lds + 98304 + (wave - 4) * 8448);
            constexpr int I_GLU = 16 * 64, I_W1 = 16 * 128, I_W2 = 64 * 32, I_KV = 16 * 64, I_Q = 16 * 32, I_O = 16 * 32;
            constexpr int NITEMS = I_GLU + 2 * I_W1 + 2 * I_W2 + I_KV + I_Q + I_O;
            for (int it = blk * 4 + (wave - 4); it < NITEMS; it += G * 4) {
                int r = it; const float* W; bf16_t* WT; int K, N, mode;
                if (r < I_GLU) { W = args.in[16]; WT = Wglu; K = DM; N = 2 * DM; mode = 1; }
                else if ((r -= I_GLU) < 2 * I_W1) { const int l = r / I_W1; r -= l * I_W1; W = args.in[6] + (size_t)l * DM * FFD; WT = W1t + (size_t)l * DM * FFD; K = DM; N = FFD; mode = 0; }
                else if ((r -= 2 * I_W1) < 2 * I_W2) { const int l = r / I_W2; r -= l * I_W2; W = args.in[7] + (size_t)l * DM * FFD; WT = W2t + (size_t)l * DM * FFD; K = FFD; N = DM; mode = 0; }
                else if ((r -= 2 * I_W2) < I_KV) { W = args.in[20]; WT = Wkv; K = DM; N = 2 * DM; mode = 2; }
                else if ((r -= I_KV) < I_Q) { W = args.in[22]; WT = Wq; K = DM; N = DM; mode = 2; }
                else { r -= I_Q; W = args.in[24]; WT = Wo; K = DM; N = DM; mode = 0; }
                const int nblk = N / 32, kb = r / nblk, nb = r - kb * nblk;
                transpose_item(W, K, N, WT, 64 * kb, 32 * nb, map_rows(mode, 32 * nb), scr, lane);
            }
        }
        }
    }
    SEAM(1);

    if (IN(2)) {
        pg8::Gemm g{Yg, Wglu, MTOK, 2 * DM, DM}; pg8::StaticOrder S; S.init(MTOK, 2 * DM, G, blk);
        pg8::EpiGlu E{x_in, X, modv + 2 * 1024};
        pg8::gemm_phase<pg8::EpiGlu>(lds, g, S, E);
    }
    SEAM(2);

#define NORM_ROW(Gv, SH, SC, OUT) do { \
        _Pragma("unroll") for (int j = 0; j < 4; ++j) { const int col = 4 * lane + 256 * j; \
            const f32x4 gg = *(const f32x4*)((Gv) + col), s4 = *(const f32x4*)((SC) + (size_t)b * MODN + col), t4 = *(const f32x4*)((SH) + (size_t)b * MODN + col); \
            const f32x4 o = v[j] * rs * gg * (1.0f + s4) + t4; u32x2 w; w.x = pk2(o[0], o[1]); w.y = pk2(o[2], o[3]); \
            *(u32x2*)((OUT) + (size_t)row * DM + col) = w; } } while (0)
#define NORM_PHASE(BODY) do { for (int row = gw; row < MTOK; row += NGW) { const int b = row >> 11; \
        const f32x4* xr = (const f32x4*)(X + (size_t)row * DM) + lane; f32x4 v[4]; float ss = 0.f; \
        _Pragma("unroll") for (int j = 0; j < 4; ++j) { v[j] = xr[64 * j]; ss += (v[j][0] * v[j][0] + v[j][1] * v[j][1]) + (v[j][2] * v[j][2] + v[j][3] * v[j][3]); } \
        const float rs = 1.0f / sqrtf(wave_sum(ss) * (1.0f / DM) + EPS); BODY } } while (0)

    if (IN(3)) { NORM_PHASE( NORM_ROW(args.in[5], modv + 3 * 1024, modv + 4 * 1024, Hb); ); }
    SEAM(3);
    if (IN(4)) {
        pg8::Gemm g{Hb, W1t, MTOK, FFD, DM}; pg8::StaticOrder S; S.init(MTOK, FFD, G, blk);
        pg8::EpiRelu2 E{Fb, FFD};
        pg8::gemm_phase<pg8::EpiRelu2>(lds, g, S, E);
    }
    SEAM(4);
    if (IN(5)) {
        pg8::Gemm g{Fb, W2t, MTOK, DM, FFD}; pg8::StaticOrder S; S.init(MTOK, DM, G, blk);
        pg8::EpiRes E{X, modv + 5 * 1024};
        pg8::gemm_phase<pg8::EpiRes>(lds, g, S, E);
    }
    SEAM(5);
    if (IN(6)) { NORM_PHASE( NORM_ROW(args.in[19], modv + 12288, modv + 13312, Hb); NORM_ROW(args.in[4] + DM, modv + 6144, modv + 6144 + 1024, Yg); ); }
    SEAM(6);
    if (IN(7)) {
#ifndef P7_NO_KV
        { pg8::Gemm g{Hb, Wkv, MTOK, 2 * DM, DM}; pg8::StaticOrder S; S.init(MTOK, 2 * DM, G, blk);
          pg8::EpiHeads<0> E{Kb, VT, args.in[21]};
          pg8::gemm_phase<pg8::EpiHeads<0>>(lds, g, S, E); }
#endif
#ifndef P7_NO_Q
        { pg8::Gemm g{Yg, Wq, MTOK, DM, DM}; pg8::StaticOrder S; S.init(MTOK, DM, G, blk);
          pg8::EpiHeads<1> E{Qb, nullptr, args.in[23]};
          pg8::gemm_phase<pg8::EpiHeads<1>>(lds, g, S, E); }
#endif
    }
    SEAM(7);

    if (IN(8)) {
        const int r32 = lane & 31, hi = lane >> 5;
        const int kperm = 16 * ((r32 >> 2) & 1) + 4 * (r32 >> 3) + (r32 & 3);
        for (int u = blk; u < NB * NHEAD * 4; u += G) {
            const int rr = u >> 8, bl = u & 255, xcd = bl & 7, cc = bl >> 3;
            const int bh = xcd * 32 + 8 * rr + (cc >> 2), qb = (cc + rr) & 3;
            const int qtA = 16 * qb + wave, qtB = 16 * qb + 15 - wave;
            const bf16_t* Qh = Qb + (size_t)bh * SEQ * HD; const bf16_t* Kh = Kb + (size_t)bh * SEQ * HD; const bf16_t* Vh = VT + (size_t)bh * HD * SEQ;
            bf16x8 qA[4], qB[4];
#pragma unroll
            for (int d0 = 0; d0 < 4; ++d0) { qA[d0] = *(const bf16x8*)(Qh + (size_t)(32 * qtA + r32) * HD + 16 * d0 + 8 * hi); qB[d0] = *(const bf16x8*)(Qh + (size_t)(32 * qtB + r32) * HD + 16 * d0 + 8 * hi); }
            f32x16 oA0, oA1, oB0, oB1;
#pragma unroll
            for (int i = 0; i < 16; ++i) { oA0[i] = 0.f; oA1[i] = 0.f; oB0[i] = 0.f; oB1[i] = 0.f; }
            float carA = 1.f, carB = 1.f;
#define ATT_TILE(QF, O0, O1, CAR, DIAG) do { \
                f32x16 s_ = {0.f, 0.f, 0.f, 0.f, 0.f, 0.f, 0.f, 0.f, 0.f, 0.f, 0.f, 0.f, 0.f, 0.f, 0.f, 0.f}; \
                _Pragma("unroll") for (int d0 = 0; d0 < 4; ++d0) s_ = __builtin_amdgcn_mfma_f32_32x32x16_bf16(kf[d0], QF[d0], s_, 0, 0, 0); \
                float be_[16], fl_[16]; \
                _Pragma("unroll") for (int i = 0; i < 16; ++i) { const float e_ = __builtin_amdgcn_exp2f(-s_[i]); const float r_ = __builtin_amdgcn_rcpf(1.0f + e_); be_[i] = r_; fl_[i] = e_ * r_; \
                    if (DIAG) { if (16 * hi + i >= r32) { be_[i] = 0.f; fl_[i] = 1.f; } } } \
                float T_ = ((fl_[0] * fl_[1]) * (fl_[2] * fl_[3])) * ((fl_[4] * fl_[5]) * (fl_[6] * fl_[7])); \
                T_ *= ((fl_[8] * fl_[9]) * (fl_[10] * fl_[11])) * ((fl_[12] * fl_[13]) * (fl_[14] * fl_[15])); \
                const float Tp_ = __shfl_xor(T_, 32); \
                float run_ = CAR * (hi ? 1.0f : Tp_); \
                _Pragma("unroll") for (int i = 15; i >= 0; --i) { be_[i] *= run_; run_ *= fl_[i]; } \
                CAR *= T_ * Tp_; \
                u32x4 p0_, p1_; \
                p0_.x = pk2(be_[0], be_[1]); p0_.y = pk2(be_[2], be_[3]); p0_.z = pk2(be_[4], be_[5]); p0_.w = pk2(be_[6], be_[7]); \
                p1_.x = pk2(be_[8], be_[9]); p1_.y = pk2(be_[10], be_[11]); p1_.z = pk2(be_[12], be_[13]); p1_.w = pk2(be_[14], be_[15]); \
                const bf16x8 w0_ = __builtin_bit_cast(bf16x8, p0_), w1_ = __builtin_bit_cast(bf16x8, p1_); \
                O0 = __builtin_amdgcn_mfma_f32_32x32x16_bf16(vf[0][0], w0_, O0, 0, 0, 0); O0 = __builtin_amdgcn_mfma_f32_32x32x16_bf16(vf[0][1], w1_, O0, 0, 0, 0); \
                O1 = __builtin_amdgcn_mfma_f32_32x32x16_bf16(vf[1][0], w0_, O1, 0, 0, 0); O1 = __builtin_amdgcn_mfma_f32_32x32x16_bf16(vf[1][1], w1_, O1, 0, 0, 0); \
            } while (0)
            for (int kt = qtB; kt >= 0; --kt) {
                bf16x8 kf[4], vf[2][2];
#pragma unroll
                for (int d0 = 0; d0 < 4; ++d0) kf[d0] = *(const bf16x8*)(Kh + (size_t)(32 * kt + kperm) * HD + 16 * d0 + 8 * hi);
#pragma unroll
                for (int dt = 0; dt < 2; ++dt)
#pragma unroll
                    for (int ks = 0; ks < 2; ++ks) vf[dt][ks] = *(const bf16x8*)(Vh + (size_t)(32 * dt + r32) * SEQ + 32 * kt + 16 * hi + 8 * ks);
                if (kt == qtB) ATT_TILE(qB, oB0, oB1, carB, true); else ATT_TILE(qB, oB0, oB1, carB, false);
                if (kt <= qtA) { if (kt == qtA) ATT_TILE(qA, oA0, oA1, carA, true); else ATT_TILE(qA, oA0, oA1, carA, false); }
            }
#undef ATT_TILE
            const int b = bh >> 4, h = bh & 15;
#define ATT_STORE(QT, O0, O1) do { bf16_t* op = Ob + ((size_t)(b * SEQ + 32 * (QT) + r32) * DM + h * HD + 4 * hi); \
                _Pragma("unroll") for (int i4 = 0; i4 < 4; ++i4) { u32x2 w; w.x = pk2(O0[4 * i4], O0[4 * i4 + 1]); w.y = pk2(O0[4 * i4 + 2], O0[4 * i4 + 3]); *(u32x2*)(op + 8 * i4) = w; \
                    u32x2 w2; w2.x = pk2(O1[4 * i4], O1[4 * i4 + 1]); w2.y = pk2(O1[4 * i4 + 2], O1[4 * i4 + 3]); *(u32x2*)(op + 32 + 8 * i4) = w2; } } while (0)
            ATT_STORE(qtA, oA0, oA1); ATT_STORE(qtB, oB0, oB1);
#undef ATT_STORE
        }
    }
    SEAM(8);
    if (IN(9)) {
        pg8::Gemm g{Ob, Wo, MTOK, DM, DM}; pg8::StaticOrder S; S.init(MTOK, DM, G, blk);
        pg8::EpiRes E{X, modv + 6144 + 2 * 1024};
        pg8::gemm_phase<pg8::EpiRes>(lds, g, S, E);
    }
    SEAM(9);
    if (IN(10)) { NORM_PHASE( NORM_ROW(args.in[5] + DM, modv + 6144 + 3 * 1024, modv + 6144 + 4 * 1024, Hb); ); }
    SEAM(10);
    if (IN(11)) {
        pg8::Gemm g{Hb, W1t + (size_t)DM * FFD, MTOK, FFD, DM}; pg8::StaticOrder S; S.init(MTOK, FFD, G, blk);
        pg8::EpiRelu2 E{Fb, FFD};
        pg8::gemm_phase<pg8::EpiRelu2>(lds, g, S, E);
    }
    SEAM(11);
    if (IN(12)) {
        pg8::Gemm g{Fb, W2t + (size_t)DM * FFD, MTOK, DM, FFD}; pg8::StaticOrder S; S.init(MTOK, DM, G, blk);
        pg8::EpiRes E{X, modv + 6144 + 5 * 1024};
        pg8::gemm_phase<pg8::EpiRes>(lds, g, S, E);
    }
#undef IN
#undef SEAM
}

extern "C" void kernel_launch(void* const* d_in, const int* in_sizes, int n_in, void* d_out, int out_size, void* d_ws, size_t ws_size, hipStream_t stream) {
    static int grid = 0;
    if (grid == 0) {
        if (n_in != 25 || out_size != MTOK * DM || ws_size < WS_END) { fprintf(stderr, "kernel_launch: unexpected shapes (n_in %d, out %d, ws %zu)\n", n_in, out_size, ws_size); grid = -1; return; }
        int dev = 0, cus = 0, per_cu = 0;
        (void)hipGetDevice(&dev); (void)hipDeviceGetAttribute(&cus, hipDeviceAttributeMultiprocessorCount, dev);
        if (hipFuncSetAttribute((const void*)yoco_fwd, hipFuncAttributeMaxDynamicSharedMemorySize, LDS_BYTES) != hipSuccess) { fprintf(stderr, "kernel_launch: hipFuncSetAttribute failed\n"); grid = -1; return; }
        if (hipOccupancyMaxActiveBlocksPerMultiprocessor(&per_cu, (const void*)yoco_fwd, NTHREADS, LDS_BYTES) != hipSuccess || per_cu < 1) { fprintf(stderr, "kernel_launch: occupancy query says %d\n", per_cu); per_cu = 1; }
        (void)hipGetLastError();
        grid = cus * 1;
        if (grid <= 0) grid = 256;
    }
    if (grid < 0) return;
    if (hipMemsetAsync((char*)d_ws + WS_CTL, 0, CTL_BYTES, stream) != hipSuccess) { fprintf(stderr, "kernel_launch: memset failed\n"); return; }
    Args a{};
    for (int i = 0; i < 25; ++i) a.in[i] = (const float*)d_in[i];
    a.out = (float*)d_out; a.ws = (unsigned char*)d_ws; a.ph_lo = 0; a.ph_hi = 13;
    void* kargs[] = {&a};
    hipError_t e = hipLaunchCooperativeKernel((const void*)yoco_fwd, dim3(grid), dim3(NTHREADS), kargs, LDS_BYTES, stream);
    if (e != hipSuccess) fprintf(stderr, "cooperative launch failed: %s (grid %d)\n", hipGetErrorString(e), grid);
}
```

```cpp
#include <hip/hip_runtime.h>
#include <hip/hip_cooperative_groups.h>
#include <cstdio>
#include <cstdint>
namespace cg = cooperative_groups;

#define LAS __attribute__((address_space(3)))
#define DI __device__ __forceinline__
typedef unsigned short bf16_t;
typedef short bf16x8 __attribute__((ext_vector_type(8)));
typedef float f32x2 __attribute__((ext_vector_type(2)));
typedef float f32x4 __attribute__((ext_vector_type(4)));
typedef float f32x16 __attribute__((ext_vector_type(16)));
typedef unsigned u32x2 __attribute__((ext_vector_type(2)));
typedef unsigned u32x4 __attribute__((ext_vector_type(4)));
typedef __bf16 bf16x2_t __attribute__((ext_vector_type(2)));

constexpr int NB = 16, SEQ = 2048, DM = 1024, MTOK = NB * SEQ, FFD = 4096, NG = 64, NP = 64, NHEAD = 16, HD = 64;
constexpr int MODN = 14336;
constexpr float EPS = 1e-6f;
constexpr float QSCALE = 0.125f * 1.4426950408889634f;
constexpr int NWAVES = 8, NTHREADS = 512;
constexpr int LDS_BYTES = 135168;

constexpr size_t MiB = 1u << 20;
constexpr size_t WS_WGLU = 0, WS_W1 = 4 * MiB, WS_W2 = 20 * MiB, WS_WKV = 36 * MiB, WS_WQ = 40 * MiB, WS_WO = 42 * MiB;
constexpr size_t WS_MOD = 44 * MiB, WS_RSTD = 45 * MiB, WS_AB = 45 * MiB + 256 * 1024, WS_BOP = 45 * MiB + 512 * 1024, WS_CM = 45 * MiB + 768 * 1024;
constexpr size_t WS_YG = 48 * MiB, WS_H = 112 * MiB, WS_F = 176 * MiB;
constexpr size_t WS_Q = 176 * MiB, WS_K = 240 * MiB, WS_VT = 304 * MiB, WS_O = 368 * MiB, WS_CTL = 432 * MiB, CTL_BYTES = 16384, WS_END = 433 * MiB;

DI unsigned pk2(float lo, float hi) { f32x2 v = {lo, hi}; bf16x2_t b = __builtin_convertvector(v, bf16x2_t); return __builtin_bit_cast(unsigned, b); }
DI float wave_sum(float v) {
#pragma unroll
    for (int o = 1; o < 64; o <<= 1) v += __shfl_xor(v, o);
    return v;
}
#define LDS_WAIT() asm volatile("s_waitcnt lgkmcnt(0)" ::: "memory")

namespace pg8 {
constexpr int BM = 256, BK = 64, HALF = 128, HTB = HALF * BK * 2, STAGE_BYTES = 8 * HTB, NXCD = 8, WGM = 8;
__host__ __device__ __forceinline__ int lds_byte(int r, int c) { const int st = (r >> 4) * 2 + (c >> 5), rr = r & 15, cc = c & 31, ob = rr * 64 + cc * 2; return st * 1024 + (ob ^ (((ob >> 9) & 1) << 5)); }
__host__ __device__ __forceinline__ void stage_rc(int b, int& R, int& C) { const int st = b / 1024, sb = b % 1024, swz = sb ^ (((sb >> 9) & 1) << 5); R = (st >> 1) * 16 + swz / 64; C = (st & 1) * 32 + (swz % 64) / 2; }
__host__ __device__ __forceinline__ int perm32(int rho) { const int n = rho >> 4, i = rho & 15; return 8 * (i >> 2) + 4 * n + (i & 3); }
struct Unit { int pm, pn; };
struct Gemm { const bf16_t* A; const bf16_t* Bt; int M, N, K; };
struct StaticOrder {
    int nM, nN, nwg, G, c;
    __device__ void init(int M, int N, int G_, int c_) { nM = M / BM; nN = N / BM; nwg = nM * nN; G = G_; c = c_; }
    __device__ bool next(int i, Unit& u) const {
        const long L = (long)i * G + c; if (L >= nwg) return false;
        int wgid = (int)L; { const int q = nwg / NXCD, r = nwg % NXCD, xcd = wgid % NXCD, off = wgid / NXCD; wgid = (xcd < r ? xcd * (q + 1) : r * (q + 1) + (xcd - r) * q) + off; }
        const int nig = WGM * nN, gid = wgid / nig, fm = gid * WGM, gsz = (nM - fm) < WGM ? (nM - fm) : WGM;
        u.pm = fm + ((wgid % nig) % gsz); u.pn = (wgid % nig) / gsz; return true;
    }
};
template <class Epi>
__device__ __forceinline__ void gemm_phase(LAS unsigned char* lds, const Gemm g, const StaticOrder& S, const Epi& E) {
    const int tid = threadIdx.x, wid = __builtin_amdgcn_readfirstlane(tid >> 6), lane = tid & 63, wr = wid >> 2, wc = wid & 3, fr = lane & 15, fq = lane >> 4;
    const int K = g.K, nt = K / BK;
    unsigned voffA[2], voffB[2];
#pragma unroll
    for (int i = 0; i < 2; ++i) { int R, C; stage_rc(tid * 16 + i * 8192, R, C); const int Rb = Epi::PERM ? ((R & ~31) + perm32(R & 31)) : R;
        voffA[i] = (unsigned)(R * K + C) * 2u; voffB[i] = (unsigned)(Rb * K + C) * 2u; }
    const size_t kstep = (size_t)(BK * 2);
    const size_t hstep = (size_t)HALF * K * 2;
    const size_t tstep = 2 * hstep;
    const unsigned ldsw = (unsigned)wid * 1024u;
    const int aoff = lds_byte(wr * 64 + fr, fq * 8), boff = lds_byte(wc * 32 + fr, fq * 8);
#define PG8_SA(b, h) (((b) * 2 + (h)) * HTB)
#define PG8_SB(b, h) ((4 + (b) * 2 + (h)) * HTB)
#define PG8_STAGE(bufoff, gbase, voff) do { _Pragma("unroll") for (int _i = 0; _i < 2; ++_i) \
        __builtin_amdgcn_global_load_lds((const unsigned*)((const char*)(gbase) + (voff)[_i]), (LAS unsigned*)(lds + (bufoff) + ldsw + _i * 8192), 16, 0, 0); } while (0)
#define PG8_LDA(dst, b, h) do { _Pragma("unroll") for (int m = 0; m < 4; ++m) _Pragma("unroll") for (int k = 0; k < 2; ++k) dst[m][k] = *(const LAS bf16x8*)(lds + PG8_SA(b, h) + aoff + m * 2048 + k * 1024); } while (0)
#define PG8_LDB(dst, b, h) do { _Pragma("unroll") for (int n = 0; n < 2; ++n) _Pragma("unroll") for (int k = 0; k < 2; ++k) dst[n][k] = *(const LAS bf16x8*)(lds + PG8_SB(b, h) + boff + n * 2048 + k * 1024); } while (0)
#define PG8_MMA(ai, bj, At, Bt) do { __builtin_amdgcn_s_setprio(1); _Pragma("unroll") for (int m = 0; m < 4; ++m) _Pragma("unroll") for (int n = 0; n < 2; ++n) _Pragma("unroll") for (int k = 0; k < 2; ++k) \
        acc[ai][bj][m][n] = __builtin_amdgcn_mfma_f32_16x16x32_bf16(Bt[n][k], At[m][k], acc[ai][bj][m][n], 0, 0, 0); __builtin_amdgcn_s_setprio(0); } while (0)
#define PG8_WAIT_V(n) asm volatile("s_waitcnt vmcnt(" #n ")" ::: "memory")
#define PG8_WAIT_L(n) asm volatile("s_waitcnt lgkmcnt(" #n ")" ::: "memory")
#define PG8_BAR __builtin_amdgcn_s_barrier()
#define PG8_SCHED __builtin_amdgcn_sched_barrier(0)
    Unit cur, nxt; int ui = 0;
    if (!S.next(0, cur)) return;
    f32x4 acc[2][2][4][2];
#pragma unroll
    for (int a = 0; a < 2; ++a)
#pragma unroll
        for (int b = 0; b < 2; ++b)
#pragma unroll
            for (int m = 0; m < 4; ++m)
#pragma unroll
                for (int n = 0; n < 2; ++n) acc[a][b][m][n] = (f32x4){0.f, 0.f, 0.f, 0.f};
    bf16x8 At[4][2], B0[2][2], B1[2][2];
    const char* cA = (const char*)g.A + (size_t)cur.pm * tstep; const char* cB = (const char*)g.Bt + (size_t)cur.pn * tstep;
    PG8_STAGE(PG8_SB(0, 0), cB, voffB); PG8_STAGE(PG8_SB(0, 1), cB + hstep, voffB); PG8_STAGE(PG8_SA(0, 0), cA, voffA); PG8_STAGE(PG8_SA(0, 1), cA + hstep, voffA);
    if (wr == 1) PG8_BAR;
    PG8_WAIT_V(2); PG8_BAR;
    PG8_STAGE(PG8_SB(1, 0), cB + kstep, voffB); PG8_STAGE(PG8_SA(1, 0), cA + kstep, voffA); PG8_STAGE(PG8_SB(1, 1), cB + hstep + kstep, voffB);
    PG8_WAIT_V(6); PG8_BAR;
    for (;;) {
        const bool has_next = S.next(ui + 1, nxt);
        const char* nA = has_next ? (const char*)g.A + (size_t)nxt.pm * tstep : cA; const char* nB = has_next ? (const char*)g.Bt + (size_t)nxt.pn * tstep : cB;
        for (int t = 0; t < nt; t += 2) {
            const bool last = (t == nt - 2);
            const char* a1 = cA + (size_t)(t + 1) * kstep;
            const char* a2 = last ? nA : cA + (size_t)(t + 2) * kstep; const char* b2 = last ? nB : cB + (size_t)(t + 2) * kstep;
            const char* a3 = a2 + kstep; const char* b3 = b2 + kstep;
            PG8_LDB(B0, 0, 0); PG8_LDB(B1, 0, 1); PG8_SCHED; PG8_LDA(At, 0, 0); PG8_STAGE(PG8_SA(1, 1), a1 + hstep, voffA);
            PG8_WAIT_V(8); PG8_WAIT_L(0); PG8_BAR; PG8_MMA(0, 0, At, B0); PG8_MMA(0, 1, At, B1); PG8_BAR; PG8_SCHED;
            PG8_LDA(At, 0, 1); PG8_STAGE(PG8_SB(0, 0), b2, voffB); PG8_STAGE(PG8_SB(0, 1), b2 + hstep, voffB); PG8_STAGE(PG8_SA(0, 0), a2, voffA);
            PG8_WAIT_V(8); PG8_WAIT_L(0); PG8_BAR; PG8_MMA(1, 0, At, B0); PG8_MMA(1, 1, At, B1); PG8_BAR; PG8_SCHED;
            PG8_LDB(B0, 1, 0); PG8_LDB(B1, 1, 1); PG8_SCHED; PG8_LDA(At, 1, 0); PG8_STAGE(PG8_SA(0, 1), a2 + hstep, voffA);
            PG8_WAIT_V(8); PG8_WAIT_L(0); PG8_BAR; PG8_MMA(0, 0, At, B0); PG8_MMA(0, 1, At, B1); PG8_BAR; PG8_SCHED;
            PG8_LDA(At, 1, 1); PG8_STAGE(PG8_SB(1, 0), b3, voffB); PG8_STAGE(PG8_SB(1, 1), b3 + hstep, voffB); PG8_STAGE(PG8_SA(1, 0), a3, voffA);
            PG8_WAIT_V(8); PG8_WAIT_L(0); PG8_BAR; PG8_MMA(1, 0, At, B0); PG8_MMA(1, 1, At, B1); PG8_BAR; PG8_SCHED;
        }
        if (wr == 0) PG8_BAR;
        E(acc, cur, wr, wc, fr, fq);
        if (!has_next) break;
#pragma unroll
        for (int a = 0; a < 2; ++a)
#pragma unroll
            for (int b = 0; b < 2; ++b)
#pragma unroll
                for (int m = 0; m < 4; ++m)
#pragma unroll
                    for (int n = 0; n < 2; ++n) acc[a][b][m][n] = (f32x4){0.f, 0.f, 0.f, 0.f};
        cur = nxt; cA = nA; cB = nB; ++ui;
        if (wr == 1) PG8_BAR;
    }
    PG8_WAIT_V(0);
    PG8_BAR;
#undef PG8_SA
#undef PG8_SB
#undef PG8_STAGE
#undef PG8_LDA
#undef PG8_LDB
#undef PG8_MMA
#undef PG8_WAIT_V
#undef PG8_WAIT_L
#undef PG8_BAR
#undef PG8_SCHED
}

DI float sigmoidf_(float v) { return __builtin_amdgcn_rcpf(1.0f + __builtin_amdgcn_exp2f(-1.4426950408889634f * v)); }

struct EpiGlu {
    static constexpr bool PERM = false;
    const float* x; float* out; const float* ga;
    DI void operator()(const f32x4 (&acc)[2][2][4][2], const Unit& u, int wr, int wc, int fr, int fq) const {
        const int row0 = u.pm * BM + wr * 64 + fr, b = (u.pm * BM) >> 11, col0 = u.pn * 128 + wc * 32 + 4 * fq;
        f32x4 gv[2];
#pragma unroll
        for (int n = 0; n < 2; ++n) gv[n] = *(const f32x4*)(ga + (size_t)b * MODN + col0 + 16 * n);
#pragma unroll
        for (int ai = 0; ai < 2; ++ai)
#pragma unroll
            for (int m = 0; m < 4; ++m) { const size_t ro = (size_t)(row0 + ai * HALF + m * 16) * DM + col0;
#pragma unroll
                for (int n = 0; n < 2; ++n) { const f32x4 xin = *(const f32x4*)(x + ro + 16 * n); const f32x4 v = acc[ai][0][m][n], gt = acc[ai][1][m][n]; f32x4 o;
#pragma unroll
                    for (int j = 0; j < 4; ++j) o[j] = xin[j] + gv[n][j] * v[j] * sigmoidf_(gt[j]);
                    *(f32x4*)(out + ro + 16 * n) = o; } }
    }
};
struct EpiRelu2 {
    static constexpr bool PERM = true;
    bf16_t* O; int ldc;
    DI void operator()(const f32x4 (&acc)[2][2][4][2], const Unit& u, int wr, int wc, int fr, int fq) const {
        const int row0 = u.pm * BM + wr * 64 + fr, col0 = u.pn * BM + wc * 32 + 8 * fq;
#pragma unroll
        for (int ai = 0; ai < 2; ++ai)
#pragma unroll
            for (int m = 0; m < 4; ++m) { bf16_t* rowp = O + (size_t)(row0 + ai * HALF + m * 16) * ldc + col0;
#pragma unroll
                for (int bj = 0; bj < 2; ++bj) { f32x4 v0 = acc[ai][bj][m][0], v1 = acc[ai][bj][m][1];
#pragma unroll
                    for (int j = 0; j < 4; ++j) { const float a = fmaxf(v0[j], 0.f), c = fmaxf(v1[j], 0.f); v0[j] = a * a; v1[j] = c * c; }
                    u32x4 w; w.x = pk2(v0[0], v0[1]); w.y = pk2(v0[2], v0[3]); w.z = pk2(v1[0], v1[1]); w.w = pk2(v1[2], v1[3]);
                    *(u32x4*)(rowp + bj * HALF) = w; } }
    }
};
struct EpiRes {
    static constexpr bool PERM = false;
    float* io; const float* gate;
    DI void operator()(const f32x4 (&acc)[2][2][4][2], const Unit& u, int wr, int wc, int fr, int fq) const {
        const int row0 = u.pm * BM + wr * 64 + fr, b = (u.pm * BM) >> 11, col0 = u.pn * BM + wc * 32 + 4 * fq;
        f32x4 gv[2][2];
#pragma unroll
        for (int bj = 0; bj < 2; ++bj)
#pragma unroll
            for (int n = 0; n < 2; ++n) gv[bj][n] = *(const f32x4*)(gate + (size_t)b * MODN + col0 + bj * HALF + 16 * n);
#pragma unroll
        for (int ai = 0; ai < 2; ++ai)
#pragma unroll
            for (int m = 0; m < 4; ++m) { float* rp = io + (size_t)(row0 + ai * HALF + m * 16) * DM + col0;
#pragma unroll
                for (int bj = 0; bj < 2; ++bj)
#pragma unroll
                    for (int n = 0; n < 2; ++n) { const f32x4 bs = *(const f32x4*)(rp + bj * HALF + 16 * n); *(f32x4*)(rp + bj * HALF + 16 * n) = bs + gv[bj][n] * acc[ai][bj][m][n]; } }
    }
};
template <int MODE> struct EpiHeads {
    static constexpr bool PERM = true;
    bf16_t* Kb; bf16_t* VT; const float* ng;
    DI void operator()(const f32x4 (&acc)[2][2][4][2], const Unit& u, int wr, int wc, int fr, int fq) const {
        const int b = (u.pm * BM) >> 11, s0 = ((u.pm * BM) & (SEQ - 1)) + wr * 64 + fr;
        const bool isV = (MODE == 0) && (u.pn >= 4);
        const int h = 4 * (u.pn & 3) + wc;
        if (!isV) {
            const float gsc = (MODE == 1) ? QSCALE : 1.0f;
#pragma unroll
            for (int ai = 0; ai < 2; ++ai)
#pragma unroll
                for (int m = 0; m < 4; ++m) { float ss = 0.f;
#pragma unroll
                    for (int bj = 0; bj < 2; ++bj)
#pragma unroll
                        for (int n = 0; n < 2; ++n) { const f32x4 v = acc[ai][bj][m][n]; ss += (v[0] * v[0] + v[1] * v[1]) + (v[2] * v[2] + v[3] * v[3]); }
                    ss += __shfl_xor(ss, 16); ss += __shfl_xor(ss, 32);
                    const float rs = __builtin_amdgcn_rsqf(ss * (1.0f / 64.0f) + EPS) * gsc;
                    bf16_t* rp = Kb + ((size_t)(b * NHEAD + h) * SEQ + (s0 + ai * HALF + m * 16)) * HD + 8 * fq;
#pragma unroll
                    for (int bj = 0; bj < 2; ++bj) { const f32x4 g0 = *(const f32x4*)(ng + 32 * bj + 8 * fq), g1 = *(const f32x4*)(ng + 32 * bj + 8 * fq + 4);
                        const f32x4 v0 = acc[ai][bj][m][0] * rs * g0, v1 = acc[ai][bj][m][1] * rs * g1;
                        u32x4 w; w.x = pk2(v0[0], v0[1]); w.y = pk2(v0[2], v0[3]); w.z = pk2(v1[0], v1[1]); w.w = pk2(v1[2], v1[3]);
                        *(u32x4*)(rp + 32 * bj) = w; }
                    asm volatile("" ::: "memory"); }
        } else {
            const unsigned loff = (unsigned)(8 * fq * SEQ + fr);
            bf16_t* ub = VT + (size_t)(b * NHEAD + h) * HD * SEQ + (((u.pm * BM) & (SEQ - 1)) + wr * 64);
#pragma unroll
            for (int ai = 0; ai < 2; ++ai)
#pragma unroll
                for (int m = 0; m < 4; ++m) {
#pragma unroll
                    for (int bj = 0; bj < 2; ++bj)
#pragma unroll
                        for (int n = 0; n < 2; ++n) { const f32x4 v = acc[ai][bj][m][n];
#pragma unroll
                            for (int j = 0; j < 4; ++j) { bf16_t* up = ub + (size_t)(32 * bj + 4 * n + j) * SEQ + (ai * HALF + m * 16); up[loff] = (bf16_t)(pk2(v[j], 0.f) & 0xffffu); } }
                    asm volatile("" ::: "memory"); }
        }
    }
};
}

DI double dexp(double x) {
    const double n = __builtin_rint(x * 1.4426950408889634);
    double r = __builtin_fma(-n, 0.6931471805599453, x); r = __builtin_fma(-n, 2.3190468138462996e-17, r);
    double p = 1.0 / 6227020800.0;
    p = p * r + 1.0 / 479001600.0; p = p * r + 1.0 / 39916800.0; p = p * r + 1.0 / 3628800.0; p = p * r + 1.0 / 362880.0; p = p * r + 1.0 / 40320.0;
    p = p * r + 1.0 / 5040.0; p = p * r + 1.0 / 720.0; p = p * r + 1.0 / 120.0; p = p * r + 1.0 / 24.0; p = p * r + 1.0 / 6.0; p = p * r + 0.5; p = p * r + 1.0; p = p * r + 1.0;
    return __builtin_ldexp(p, (int)n);
}
DI void dsincos(double a, double& s, double& c) {
    const double q = __builtin_rint(a * 0.6366197723675814);
    double r = __builtin_fma(-q, 1.5707963267948966, a); r = __builtin_fma(-q, 6.123233995736766e-17, r);
    const int qi = ((int)q) & 3; const double r2 = r * r;
    double sp = -1.0 / 1307674368000.0; sp = sp * r2 + 1.0 / 6227020800.0; sp = sp * r2 - 1.0 / 39916800.0; sp = sp * r2 + 1.0 / 362880.0; sp = sp * r2 - 1.0 / 5040.0; sp = sp * r2 + 1.0 / 120.0; sp = sp * r2 - 1.0 / 6.0; sp = sp * r2 + 1.0; sp = sp * r;
    double cp = 1.0 / 20922789888000.0; cp = cp * r2 - 1.0 / 87178291200.0; cp = cp * r2 + 1.0 / 479001600.0; cp = cp * r2 - 1.0 / 3628800.0; cp = cp * r2 + 1.0 / 40320.0; cp = cp * r2 - 1.0 / 720.0; cp = cp * r2 + 1.0 / 24.0; cp = cp * r2 - 0.5; cp = cp * r2 + 1.0;
    s = (qi == 0) ? sp : (qi == 1) ? cp : (qi == 2) ? -sp : -cp;
    c = (qi == 0) ? cp : (qi == 1) ? -sp : (qi == 2) ? -cp : sp;
}

DI void transpose_item(const float* __restrict__ W, int K, int N, bf16_t* __restrict__ WT, int k0, int n0, int drow0, LAS float* scr, int lane) {
#pragma unroll 8
    for (int i = 0; i < 32; ++i) { const int kk = 2 * i + (lane >> 5); scr[kk * 33 + (lane & 31)] = W[(size_t)(k0 + kk) * N + n0 + (lane & 31)]; }
    LDS_WAIT();
    const int c = lane & 7;
#pragma unroll
    for (int j = 0; j < 4; ++j) { const int n = (lane >> 3) + 8 * j; const LAS float* s = scr + (8 * c) * 33 + n;
        u32x4 o; o.x = pk2(s[0 * 33], s[1 * 33]); o.y = pk2(s[2 * 33], s[3 * 33]); o.z = pk2(s[4 * 33], s[5 * 33]); o.w = pk2(s[6 * 33], s[7 * 33]);
        *(u32x4*)(WT + (size_t)(drow0 + n) * K + k0 + 8 * c) = o; }
    LDS_WAIT();
}
DI int map_rows(int mode, int n0) {
    if (mode == 1) { const int bj = n0 >> 10, rem = n0 & 1023; return 256 * (rem >> 7) + 128 * bj + (rem & 127); }
    if (mode == 2) { const int tile = n0 >> 8, off = n0 & 255; return 256 * tile + 128 * ((off & 63) >> 5) + 32 * (off >> 6); }
    return n0;
}

#define XB_TMO      128
#define XB_XCNT(j)  (256  + 64 * (j))
#define XB_XSUB(j)  (1280 + 64 * (j))
#define XB_XGEN(j)  (2304 + 64 * (j))
#define XB_TOP      3328
#define XB_TOPGEN   3392
#define XCD_BAR_WORDS 3456
#define XB_SPIN_CAP (1u << 22)
DI unsigned xb_ld(unsigned* p)              { return __hip_atomic_load(p, __ATOMIC_RELAXED, __HIP_MEMORY_SCOPE_AGENT); }
DI unsigned xb_add(unsigned* p, unsigned v) { return __hip_atomic_fetch_add(p, v, __ATOMIC_RELAXED, __HIP_MEMORY_SCOPE_AGENT); }
DI unsigned xb_xcc_id() { return (unsigned)__builtin_amdgcn_s_getreg((3 << 11) | 20) & 0xFu; }
#define XB_SPIN(cond, bar) do { unsigned _sp = 0; while (cond) { __builtin_amdgcn_s_sleep(1); \
    if ((++_sp & 255u) == 0u) { if (xb_ld(&(bar)[XB_TMO])) break; if (_sp > XB_SPIN_CAP) { atomicAdd(&(bar)[XB_TMO], 1u); break; } } } } while (0)
struct XcdBarrier { unsigned* bar; unsigned x; volatile LAS unsigned* st; };
DI XcdBarrier xcd_barrier_post(unsigned* bar, volatile LAS unsigned* st) {
    XcdBarrier b; b.bar = bar; b.x = xb_xcc_id(); b.st = st;
    if (threadIdx.x == 0) (void)xb_add(&bar[XB_XCNT(b.x)], 1u);
    return b;
}
DI void xcd_barrier_complete(unsigned* bar, unsigned x, unsigned& nloc, unsigned& nx) {
    const unsigned G = gridDim.x * gridDim.y * gridDim.z;
    unsigned sum, cnt, mine, sp = 0u;
    for (;;) {
        sum = 0u; cnt = 0u; mine = 0u;
#pragma unroll
        for (unsigned j = 0; j < 16; ++j) { const unsigned c = xb_ld(&bar[XB_XCNT(j)]); sum += c; cnt += (c > 0u) ? 1u : 0u; mine = (j == x) ? c : mine; }
        if (sum == G) break;
        __builtin_amdgcn_s_sleep(1);
        if ((++sp & 255u) == 0u) { if (xb_ld(&bar[XB_TMO])) break; if (sp > XB_SPIN_CAP) { atomicAdd(&bar[XB_TMO], 1u); break; } }
    }
    nloc = mine > 0u ? mine : 1u; nx = cnt > 0u ? cnt : 1u;
}
DI void xcd_barrier(const XcdBarrier& b) {
    asm volatile("s_waitcnt vmcnt(0)" ::: "memory");
    __syncthreads();
    if (threadIdx.x == 0) {
        unsigned* bar = b.bar;
        __builtin_amdgcn_s_waitcnt(0);
        unsigned nloc = b.st[0], nx = b.st[1];
        if (nloc == 0u) { xcd_barrier_complete(bar, b.x, nloc, nx); b.st[0] = nloc; b.st[1] = nx; }
        const unsigned old = xb_add(&bar[XB_XSUB(b.x)], 1u);
        const unsigned gen = old / nloc;
        if (old + 1u == (gen + 1u) * nloc) {
            __builtin_amdgcn_fence(__ATOMIC_RELEASE, "agent");
            asm volatile("s_waitcnt vmcnt(0)" ::: "memory");
            const unsigned og = xb_add(&bar[XB_TOP], 1u);
            const unsigned tg = og / nx;
            if (og + 1u == (tg + 1u) * nx) xb_add(&bar[XB_TOPGEN], 1u);
            else XB_SPIN(xb_ld(&bar[XB_TOPGEN]) == tg, bar);
            __builtin_amdgcn_fence(__ATOMIC_ACQUIRE, "agent");
            xb_add(&bar[XB_XGEN(b.x)], 1u);
            asm volatile("s_waitcnt vmcnt(0)" ::: "memory");
        } else {
            XB_SPIN(xb_ld(&bar[XB_XGEN(b.x)]) == gen, bar);
            __builtin_amdgcn_fence(__ATOMIC_ACQUIRE, "agent");
            asm volatile("s_waitcnt vmcnt(0)" ::: "memory");
        }
    }
    __syncthreads();
}

struct Args { const float* in[25]; float* out; unsigned char* ws; int ph_lo, ph_hi; };

__global__ void __launch_bounds__(NTHREADS, 2) yoco_fwd(Args args) {
    extern __shared__ __attribute__((aligned(16))) unsigned char lds_raw[];
    LAS unsigned char* lds = (LAS unsigned char*)lds_raw;
    cg::grid_group grid = cg::this_grid();
    const int tid = threadIdx.x, lane = tid & 63, wave = __builtin_amdgcn_readfirstlane(tid >> 6);
    const int G = gridDim.x, blk = blockIdx.x;
    const int gw = blk * NWAVES + wave, NGW = G * NWAVES;
    unsigned char* ws = args.ws;
    const float* x_in = args.in[0];
    float* X = args.out;
    bf16_t* Wglu = (bf16_t*)(ws + WS_WGLU); bf16_t* W1t = (bf16_t*)(ws + WS_W1); bf16_t* W2t = (bf16_t*)(ws + WS_W2);
    bf16_t* Wkv = (bf16_t*)(ws + WS_WKV); bf16_t* Wq = (bf16_t*)(ws + WS_WQ); bf16_t* Wo = (bf16_t*)(ws + WS_WO);
    float* modv = (float*)(ws + WS_MOD); float* rstd0 = (float*)(ws + WS_RSTD);
    f32x2* abv = (f32x2*)(ws + WS_AB); bf16_t* Bop = (bf16_t*)(ws + WS_BOP); bf16_t* Cm = (bf16_t*)(ws + WS_CM);
    bf16_t* Yg = (bf16_t*)(ws + WS_YG); bf16_t* Hb = (bf16_t*)(ws + WS_H); bf16_t* Fb = (bf16_t*)(ws + WS_F);
    bf16_t* Qb = (bf16_t*)(ws + WS_Q); bf16_t* Kb = (bf16_t*)(ws + WS_K); bf16_t* VT = (bf16_t*)(ws + WS_VT); bf16_t* Ob = (bf16_t*)(ws + WS_O);
    const int lo = args.ph_lo, hi_ph = args.ph_hi;
#ifndef PHMASK
#define PHMASK 0x1fff
#endif
#ifndef ATT_REP
#define ATT_REP 1
#endif
#ifndef S5_REP
#define S5_REP 1
#endif
#define PH(k) if (IN(k))
#define IN(k) (((PHMASK >> (k)) & 1) && lo <= (k) && (k) < hi_ph)
    volatile LAS unsigned* MISC = (volatile LAS unsigned*)(lds + LDS_BYTES - 256);
    if (tid < 16) MISC[tid] = 0u;
    __syncthreads();
    const XcdBarrier xbar = xcd_barrier_post((unsigned*)(ws + WS_CTL), MISC + 8);
#define SEAM(k) do { if (IN(k) && IN((k) + 1)) { if ((k) == 0) grid.sync(); else xcd_barrier(xbar); } } while (0)

    PH(0) {
        {
            LAS float* sc = (LAS float*)lds;
            LAS float* red = (LAS float*)(lds + 65536);
            const float* cvec = args.in[1];
            bool have_sc = false;
            for (int cb = blk; cb < MODN / 64; cb += G) {
                if (!have_sc) {
                    for (int i = tid; i < NB * DM; i += NTHREADS) { const float v = cvec[i]; sc[(i & 1023) * 16 + (i >> 10)] = v / (1.0f + __expf(-v)); }
                    __syncthreads(); have_sc = true;
                }
                const int e = cb * 64 + lane;
                const float* Wp; int stride; const float* bias;
                if (e < 12288) { const int l = e / 6144, ee = e - l * 6144; Wp = args.in[2] + (size_t)l * DM * 6144 + ee; stride = 6144; bias = args.in[3] + l * 6144 + ee; }
                else { const int ee = e - 12288; Wp = args.in[17] + ee; stride = 2048; bias = args.in[18] + ee; }
                float a[16];
#pragma unroll
                for (int b = 0; b < 16; ++b) a[b] = 0.f;
                const int d0 = wave * 128;
#pragma unroll 4
                for (int d = 0; d < 128; ++d) { const float w = Wp[(size_t)(d0 + d) * stride];
                    const LAS f32x4* sp = (const LAS f32x4*)(sc + (d0 + d) * 16);
#pragma unroll
                    for (int q = 0; q < 4; ++q) { const f32x4 s4 = sp[q]; a[4 * q] += w * s4[0]; a[4 * q + 1] += w * s4[1]; a[4 * q + 2] += w * s4[2]; a[4 * q + 3] += w * s4[3]; } }
#pragma unroll
                for (int b = 0; b < 16; ++b) red[(wave * 16 + b) * 64 + lane] = a[b];
                __syncthreads();
                for (int o = tid; o < 1024; o += NTHREADS) { const int b = o >> 6, cl = o & 63; float s = 0.f;
#pragma unroll
                    for (int w8 = 0; w8 < 8; ++w8) s += red[(w8 * 16 + b) * 64 + cl];
                    const int ee = cb * 64 + cl; const float bs = (ee < 12288) ? args.in[3][ee] : args.in[18][ee - 12288];
                    modv[(size_t)b * MODN + ee] = s + bs; }
                __syncthreads();
                (void)bias;
            }
            __syncthreads();
        }
        for (int i = blk * NTHREADS + tid; i < NG * NP; i += G * NTHREADS) {
            const int g = i >> 6, p = i & 63;
            const double lre = (double)args.in[8][i], lim = (double)args.in[9][i], dt = dexp((double)args.in[10][g]);
            const double mag = dexp(lre * dt); double sn, cs; dsincos(lim * dt, sn, cs);
            const double are = mag * cs, aim = mag * sn, den = lre * lre + lim * lim, nr = are - 1.0, ni = aim;
            const double fre = (nr * lre + ni * lim) / den, fim = (ni * lre - nr * lim) / den;
            abv[i] = (f32x2){(float)are, (float)aim};
            const float* bre = args.in[11] + (size_t)i * 16; const float* bim = args.in[12] + (size_t)i * 16;
#pragma unroll
            for (int h = 0; h < 16; h += 2) {
                const double br0 = bre[h], bi0 = bim[h], br1 = bre[h + 1], bi1 = bim[h + 1];
                *(unsigned*)(Bop + ((size_t)(g * 128 + 2 * p) * 16 + h)) = pk2((float)(fre * br0 - fim * bi0), (float)(fre * br1 - fim * bi1));
                *(unsigned*)(Bop + ((size_t)(g * 128 + 2 * p + 1) * 16 + h)) = pk2((float)(fre * bi0 + fim * br0), (float)(fre * bi1 + fim * br1));
            }
#pragma unroll
            for (int h = 0; h < 16; ++h) {
                const float cr = args.in[13][(size_t)(g * 16 + h) * 64 + p], ci = args.in[14][(size_t)(g * 16 + h) * 64 + p];
                *(unsigned*)(Cm + ((size_t)(g * 16 + h) * 128 + 2 * p)) = pk2(cr, -ci);
            }
        }
        for (int row = gw; row < MTOK; row += NGW) {
            const f32x4* xr = (const f32x4*)(x_in + (size_t)row * DM) + lane; float ss = 0.f;
#pragma unroll
            for (int j = 0; j < 4; ++j) { const f32x4 v = xr[64 * j]; ss += (v[0] * v[0] + v[1] * v[1]) + (v[2] * v[2] + v[3] * v[3]); }
            ss = wave_sum(ss);
            if (lane == 0) rstd0[row] = 1.0f / sqrtf(ss * (1.0f / DM) + EPS);
        }
    }
    SEAM(0);

    PH(1) {
        if (wave < 4) {
            LAS float* BUl = (LAS float*)(lds + wave * 24576);
            LAS unsigned* Sl = (LAS unsigned*)(lds + wave * 24576 + 16384);
            const int r32 = lane & 31, hi = lane >> 5, fr = lane & 15, fq = lane >> 4;
            const float* sh_a = modv + 0 * 1024; const float* sc_a = modv + 1 * 1024; const float* gmix = args.in[4]; const float* dsk = args.in[15];
            for (int pp = blk * 4 + wave; pp < NB * NG * S5_REP; pp += G * 4) {
                const int pair = pp & 1023;
                const int b = pair >> 6, g = pair & 63;
                float gs[8], shv[8];
#pragma unroll
                for (int j = 0; j < 8; ++j) { const int ch = 16 * g + 8 * hi + j; gs[j] = gmix[ch] * (1.0f + sc_a[(size_t)b * MODN + ch]); shv[j] = sh_a[(size_t)b * MODN + ch]; }
                float gs4[4], sh4[4], d4[4];
#pragma unroll
                for (int j = 0; j < 4; ++j) { const int ch = 16 * g + 4 * fq + j; gs4[j] = gmix[ch] * (1.0f + sc_a[(size_t)b * MODN + ch]); sh4[j] = sh_a[(size_t)b * MODN + ch]; d4[j] = dsk[ch]; }
                bf16x8 bfrag[4], cfrag[4];
#pragma unroll
                for (int pt = 0; pt < 4; ++pt) bfrag[pt] = *(const bf16x8*)(Bop + ((size_t)(g * 128 + 32 * pt + r32) * 16 + 8 * hi));
#pragma unroll
                for (int ks = 0; ks < 4; ++ks) cfrag[ks] = *(const bf16x8*)(Cm + ((size_t)(g * 16 + fr) * 128 + 32 * ks + 8 * fq));
                const f32x2 ab = abv[g * 64 + lane];
                float s_re = 0.f, s_im = 0.f;
                const float* xb = x_in + (size_t)b * SEQ * DM + 16 * g;
                const float* rsb = rstd0 + (size_t)b * SEQ;
                f32x4 nx0 = *(const f32x4*)(xb + (size_t)r32 * DM + 8 * hi), nx1 = *(const f32x4*)(xb + (size_t)r32 * DM + 8 * hi + 4); float nrs = rsb[r32];
                for (int c = 0; c < SEQ / 32; ++c) {
                    const int t0 = 32 * c;
                    const f32x4 x0 = nx0, x1 = nx1; const float rs = nrs;
                    if (c + 1 < SEQ / 32) { const float* xp = xb + (size_t)(t0 + 32 + r32) * DM + 8 * hi; nx0 = *(const f32x4*)xp; nx1 = *(const f32x4*)(xp + 4); nrs = rsb[t0 + 32 + r32]; }
                    f32x4 exv[2]; float ers[2];
#pragma unroll
                    for (int nt = 0; nt < 2; ++nt) { exv[nt] = *(const f32x4*)(xb + (size_t)(t0 + 16 * nt + fr) * DM + 4 * fq); ers[nt] = rsb[t0 + 16 * nt + fr]; }
                    u32x4 up;
                    up.x = pk2(x0[0] * rs * gs[0] + shv[0], x0[1] * rs * gs[1] + shv[1]); up.y = pk2(x0[2] * rs * gs[2] + shv[2], x0[3] * rs * gs[3] + shv[3]);
                    up.z = pk2(x1[0] * rs * gs[4] + shv[4], x1[1] * rs * gs[5] + shv[5]); up.w = pk2(x1[2] * rs * gs[6] + shv[6], x1[3] * rs * gs[7] + shv[7]);
                    const bf16x8 ua = __builtin_bit_cast(bf16x8, up);
#pragma unroll
                    for (int pt = 0; pt < 4; ++pt) {
                        f32x16 z = {0.f, 0.f, 0.f, 0.f, 0.f, 0.f, 0.f, 0.f, 0.f, 0.f, 0.f, 0.f, 0.f, 0.f, 0.f, 0.f};
                        z = __builtin_amdgcn_mfma_f32_32x32x16_bf16(ua, bfrag[pt], z, 0, 0, 0);
#pragma unroll
                        for (int i = 0; i < 16; ++i) BUl[((i & 3) + 8 * (i >> 2) + 4 * hi) * 128 + 32 * pt + r32] = z[i];
                    }
                    LDS_WAIT();
#pragma unroll
                    for (int t = 0; t < 32; ++t) {
                        const f32x2 bu = *(const LAS f32x2*)(BUl + t * 128 + 2 * lane);
                        const float nr = ab[0] * s_re - ab[1] * s_im + bu[0];
                        const float ni = ab[0] * s_im + ab[1] * s_re + bu[1];
                        s_re = nr; s_im = ni;
                        Sl[t * 64 + lane] = pk2(s_re, s_im);
                    }
                    LDS_WAIT();
#pragma unroll
                    for (int nt = 0; nt < 2; ++nt) {
                        f32x4 acc = {0.f, 0.f, 0.f, 0.f};
#pragma unroll
                        for (int ks = 0; ks < 4; ++ks) { const bf16x8 sf = *(const LAS bf16x8*)((const LAS unsigned char*)Sl + (16 * nt + fr) * 256 + 64 * ks + 16 * fq);
                            acc = __builtin_amdgcn_mfma_f32_16x16x32_bf16(cfrag[ks], sf, acc, 0, 0, 0); }
                        const int t = t0 + 16 * nt + fr;
                        const f32x4 xv = exv[nt]; const float rs2 = ers[nt];
                        float yo[4];
#pragma unroll
                        for (int j = 0; j < 4; ++j) { const float u = xv[j] * rs2 * gs4[j] + sh4[j]; const float y = acc[j] + d4[j] * u;
                            const float kk = 0.7978845608028654f * (y + 0.044715f * y * y * y);
                            yo[j] = y * __builtin_amdgcn_rcpf(1.0f + __builtin_amdgcn_exp2f(-2.0f * 1.4426950408889634f * kk)); }
                        u32x2 o2; o2.x = pk2(yo[0], yo[1]); o2.y = pk2(yo[2], yo[3]);
                        *(u32x2*)(Yg + ((size_t)(b * SEQ + t) * DM + 16 * g + 4 * fq)) = o2;
                    }
                    LDS_WAIT();
                }
            }
        } else {
        {
            LAS float* scr = (LAS float*)(lds + 98304 + (wave - 4) * 8448);
            constexpr int I_GLU = 16 * 64, I_W1 = 16 * 128, I_W2 = 64 * 32, I_KV = 16 * 64, I_Q = 16 * 32, I_O = 16 * 32;
            constexpr int NITEMS = I_GLU + 2 * I_W1 + 2 * I_W2 + I_KV + I_Q + I_O;
            for (int it = blk * 4 + (wave - 4); it < NITEMS; it += G * 4) {
                int r = it; const float* W; bf16_t* WT; int K, N, mode;
                if (r < I_GLU) { W = args.in[16]; WT = Wglu; K = DM; N = 2 * DM; mode = 1; }
                else if ((r -= I_GLU) < 2 * I_W1) { const int l = r / I_W1; r -= l * I_W1; W = args.in[6] + (size_t)l * DM * FFD; WT = W1t + (size_t)l * DM * FFD; K = DM; N = FFD; mode = 0; }
                else if ((r -= 2 * I_W1) < 2 * I_W2) { const int l = r / I_W2; r -= l * I_W2; W = args.in[7] + (size_t)l * DM * FFD; WT = W2t + (size_t)l * DM * FFD; K = FFD; N = DM; mode = 0; }
                else if ((r -= 2 * I_W2) < I_KV) { W = args.in[20]; WT = Wkv; K = DM; N = 2 * DM; mode = 2; }
                else if ((r -= I_KV) < I_Q) { W = args.in[22]; WT = Wq; K = DM; N = DM; mode = 2; }
                else { r -= I_Q; W = args.in[24]; WT = Wo; K = DM; N = DM; mode = 0; }
                const int nblk = N / 32, kb = r / nblk, nb = r - kb * nblk;
                transpose_item(W, K, N, WT, 64 * kb, 32 * nb, map_rows(mode, 32 * nb), scr, lane);
            }
        }
        }
    }
    SEAM(1);

    PH(2) {
        pg8::Gemm g{Yg, Wglu, MTOK, 2 * DM, DM}; pg8::StaticOrder S; S.init(MTOK, 2 * DM, G, blk);
        pg8::EpiGlu E{x_in, X, modv + 2 * 1024};
        pg8::gemm_phase<pg8::EpiGlu>(lds, g, S, E);
    }
    SEAM(2);

#define NORM_ROW(Gv, SH, SC, OUT) do { \
        _Pragma("unroll") for (int j = 0; j < 4; ++j) { const int col = 4 * lane + 256 * j; \
            const f32x4 gg = *(const f32x4*)((Gv) + col), s4 = *(const f32x4*)((SC) + (size_t)b * MODN + col), t4 = *(const f32x4*)((SH) + (size_t)b * MODN + col); \
            const f32x4 o = v[j] * rs * gg * (1.0f + s4) + t4; u32x2 w; w.x = pk2(o[0], o[1]); w.y = pk2(o[2], o[3]); \
            *(u32x2*)((OUT) + (size_t)row * DM + col) = w; } } while (0)
#define NORM_PHASE(BODY) do { for (int row = gw; row < MTOK; row += NGW) { const int b = row >> 11; \
        const f32x4* xr = (const f32x4*)(X + (size_t)row * DM) + lane; f32x4 v[4]; float ss = 0.f; \
        _Pragma("unroll") for (int j = 0; j < 4; ++j) { v[j] = xr[64 * j]; ss += (v[j][0] * v[j][0] + v[j][1] * v[j][1]) + (v[j][2] * v[j][2] + v[j][3] * v[j][3]); } \
        const float rs = 1.0f / sqrtf(wave_sum(ss) * (1.0f / DM) + EPS); BODY } } while (0)

    PH(3) { NORM_PHASE( NORM_ROW(args.in[5], modv + 3 * 1024, modv + 4 * 1024, Hb); ); }
    SEAM(3);
    PH(4) {
        pg8::Gemm g{Hb, W1t, MTOK, FFD, DM}; pg8::StaticOrder S; S.init(MTOK, FFD, G, blk);
        pg8::EpiRelu2 E{Fb, FFD};
        pg8::gemm_phase<pg8::EpiRelu2>(lds, g, S, E);
    }
    SEAM(4);
    PH(5) {
        pg8::Gemm g{Fb, W2t, MTOK, DM, FFD}; pg8::StaticOrder S; S.init(MTOK, DM, G, blk);
        pg8::EpiRes E{X, modv + 5 * 1024};
        pg8::gemm_phase<pg8::EpiRes>(lds, g, S, E);
    }
    SEAM(5);
    PH(6) { NORM_PHASE( NORM_ROW(args.in[19], modv + 12288, modv + 13312, Hb); NORM_ROW(args.in[4] + DM, modv + 6144, modv + 6144 + 1024, Yg); ); }
    SEAM(6);
    PH(7) {
#ifndef P7_NO_KV
        { pg8::Gemm g{Hb, Wkv, MTOK, 2 * DM, DM}; pg8::StaticOrder S; S.init(MTOK, 2 * DM, G, blk);
          pg8::EpiHeads<0> E{Kb, VT, args.in[21]};
          pg8::gemm_phase<pg8::EpiHeads<0>>(lds, g, S, E); }
#endif
#ifndef P7_NO_Q
        { pg8::Gemm g{Yg, Wq, MTOK, DM, DM}; pg8::StaticOrder S; S.init(MTOK, DM, G, blk);
          pg8::EpiHeads<1> E{Qb, nullptr, args.in[23]};
          pg8::gemm_phase<pg8::EpiHeads<1>>(lds, g, S, E); }
#endif
    }
    SEAM(7);

    PH(8) {
        const int r32 = lane & 31, hi = lane >> 5;
        const int kperm = 16 * ((r32 >> 2) & 1) + 4 * (r32 >> 3) + (r32 & 3);
        for (int uu = blk; uu < NB * NHEAD * 4 * ATT_REP; uu += G) {
            const int u = uu & 1023; const int rr = u >> 8, bl = u & 255, xcd = bl & 7, cc = bl >> 3;
            const int bh = xcd * 32 + 8 * rr + (cc >> 2), qb = (cc + rr) & 3;
            const int qtA = 16 * qb + wave, qtB = 16 * qb + 15 - wave;
            const bf16_t* Qh = Qb + (size_t)bh * SEQ * HD; const bf16_t* Kh = Kb + (size_t)bh * SEQ * HD; const bf16_t* Vh = VT + (size_t)bh * HD * SEQ;
            bf16x8 qA[4], qB[4];
#pragma unroll
            for (int d0 = 0; d0 < 4; ++d0) { qA[d0] = *(const bf16x8*)(Qh + (size_t)(32 * qtA + r32) * HD + 16 * d0 + 8 * hi); qB[d0] = *(const bf16x8*)(Qh + (size_t)(32 * qtB + r32) * HD + 16 * d0 + 8 * hi); }
            f32x16 oA0, oA1, oB0, oB1;
#pragma unroll
            for (int i = 0; i < 16; ++i) { oA0[i] = 0.f; oA1[i] = 0.f; oB0[i] = 0.f; oB1[i] = 0.f; }
            float carA = 1.f, carB = 1.f;
#define ATT_TILE(KF, VF, QF, O0, O1, CAR, DIAG) do { \
                f32x16 s_ = {0.f, 0.f, 0.f, 0.f, 0.f, 0.f, 0.f, 0.f, 0.f, 0.f, 0.f, 0.f, 0.f, 0.f, 0.f, 0.f}; \
                _Pragma("unroll") for (int d0 = 0; d0 < 4; ++d0) s_ = __builtin_amdgcn_mfma_f32_32x32x16_bf16(KF[d0], QF[d0], s_, 0, 0, 0); \
                float be_[16], fl_[16]; \
                _Pragma("unroll") for (int i = 0; i < 16; ++i) { const float e_ = __builtin_amdgcn_exp2f(-s_[i]); const float r_ = __builtin_amdgcn_rcpf(1.0f + e_); be_[i] = r_; fl_[i] = e_ * r_; \
                    if (DIAG) { if (16 * hi + i >= r32) { be_[i] = 0.f; fl_[i] = 1.f; } } } \
                float T_ = ((fl_[0] * fl_[1]) * (fl_[2] * fl_[3])) * ((fl_[4] * fl_[5]) * (fl_[6] * fl_[7])); \
                T_ *= ((fl_[8] * fl_[9]) * (fl_[10] * fl_[11])) * ((fl_[12] * fl_[13]) * (fl_[14] * fl_[15])); \
                const auto sw_ = __builtin_amdgcn_permlane32_swap(__float_as_uint(T_), __float_as_uint(T_), false, false); \
                const float Tlo_ = __uint_as_float(sw_[0]), Thi_ = __uint_as_float(sw_[1]); \
                float run_ = CAR * (hi ? 1.0f : Thi_); \
                _Pragma("unroll") for (int i = 15; i >= 0; --i) { be_[i] *= run_; run_ *= fl_[i]; } \
                CAR *= Tlo_ * Thi_; \
                u32x4 p0_, p1_; \
                p0_.x = pk2(be_[0], be_[1]); p0_.y = pk2(be_[2], be_[3]); p0_.z = pk2(be_[4], be_[5]); p0_.w = pk2(be_[6], be_[7]); \
                p1_.x = pk2(be_[8], be_[9]); p1_.y = pk2(be_[10], be_[11]); p1_.z = pk2(be_[12], be_[13]); p1_.w = pk2(be_[14], be_[15]); \
                const bf16x8 w0_ = __builtin_bit_cast(bf16x8, p0_), w1_ = __builtin_bit_cast(bf16x8, p1_); \
                O0 = __builtin_amdgcn_mfma_f32_32x32x16_bf16(VF[0][0], w0_, O0, 0, 0, 0); O0 = __builtin_amdgcn_mfma_f32_32x32x16_bf16(VF[0][1], w1_, O0, 0, 0, 0); \
                O1 = __builtin_amdgcn_mfma_f32_32x32x16_bf16(VF[1][0], w0_, O1, 0, 0, 0); O1 = __builtin_amdgcn_mfma_f32_32x32x16_bf16(VF[1][1], w1_, O1, 0, 0, 0); \
            } while (0)
#define ATT_LOAD(KF, VF, KT) do { \
                _Pragma("unroll") for (int d0 = 0; d0 < 4; ++d0) KF[d0] = *(const bf16x8*)(Kh + (size_t)(32 * (KT) + kperm) * HD + 16 * d0 + 8 * hi); \
                _Pragma("unroll") for (int dt = 0; dt < 2; ++dt) _Pragma("unroll") for (int ks = 0; ks < 2; ++ks) VF[dt][ks] = *(const bf16x8*)(Vh + (size_t)(32 * dt + r32) * SEQ + 32 * (KT) + 16 * hi + 8 * ks); \
            } while (0)
#define ATT_STEP(KF, VF, KFN, VFN, KT) do { \
                if ((KT) > 0) ATT_LOAD(KFN, VFN, (KT) - 1); \
                ATT_TILE(KF, VF, qB, oB0, oB1, carB, false); \
                if ((KT) <= qtA) { if ((KT) == qtA) ATT_TILE(KF, VF, qA, oA0, oA1, carA, true); else ATT_TILE(KF, VF, qA, oA0, oA1, carA, false); } \
            } while (0)
            bf16x8 kf0[4], vf0[2][2], kf1[4], vf1[2][2];
            ATT_LOAD(kf0, vf0, qtB);
            ATT_LOAD(kf1, vf1, qtB - 1);
            ATT_TILE(kf0, vf0, qB, oB0, oB1, carB, true);
            for (int kt = qtB - 1; kt >= 0; kt -= 2) {
                ATT_STEP(kf1, vf1, kf0, vf0, kt);
                if (kt - 1 >= 0) ATT_STEP(kf0, vf0, kf1, vf1, kt - 1);
            }
#undef ATT_STEP
#undef ATT_LOAD
#undef ATT_TILE
            const int b = bh >> 4, h = bh & 15;
#define ATT_STORE(QT, O0, O1) do { bf16_t* op = Ob + ((size_t)(b * SEQ + 32 * (QT) + r32) * DM + h * HD + 4 * hi); \
                _Pragma("unroll") for (int i4 = 0; i4 < 4; ++i4) { u32x2 w; w.x = pk2(O0[4 * i4], O0[4 * i4 + 1]); w.y = pk2(O0[4 * i4 + 2], O0[4 * i4 + 3]); *(u32x2*)(op + 8 * i4) = w; \
                    u32x2 w2; w2.x = pk2(O1[4 * i4], O1[4 * i4 + 1]); w2.y = pk2(O1[4 * i4 + 2], O1[4 * i4 + 3]); *(u32x2*)(op + 32 + 8 * i4) = w2; } } while (0)
            ATT_STORE(qtA, oA0, oA1); ATT_STORE(qtB, oB0, oB1);
#undef ATT_STORE
        }
    }
    SEAM(8);
    PH(9) {
        pg8::Gemm g{Ob, Wo, MTOK, DM, DM}; pg8::StaticOrder S; S.init(MTOK, DM, G, blk);
        pg8::EpiRes E{X, modv + 6144 + 2 * 1024};
        pg8::gemm_phase<pg8::EpiRes>(lds, g, S, E);
    }
    SEAM(9);
    PH(10) { NORM_PHASE( NORM_ROW(args.in[5] + DM, modv + 6144 + 3 * 1024, modv + 6144 + 4 * 1024, Hb); ); }
    SEAM(10);
    PH(11) {
        pg8::Gemm g{Hb, W1t + (size_t)DM * FFD, MTOK, FFD, DM}; pg8::StaticOrder S; S.init(MTOK, FFD, G, blk);
        pg8::EpiRelu2 E{Fb, FFD};
        pg8::gemm_phase<pg8::EpiRelu2>(lds, g, S, E);
    }
    SEAM(11);
    PH(12) {
        pg8::Gemm g{Fb, W2t + (size_t)DM * FFD, MTOK, DM, FFD}; pg8::StaticOrder S; S.init(MTOK, DM, G, blk);
        pg8::EpiRes E{X, modv + 6144 + 5 * 1024};
        pg8::gemm_phase<pg8::EpiRes>(lds, g, S, E);
    }
#undef IN
#undef SEAM
}

extern "C" void kernel_launch(void* const* d_in, const int* in_sizes, int n_in, void* d_out, int out_size, void* d_ws, size_t ws_size, hipStream_t stream) {
    static int grid = 0;
    if (grid == 0) {
        if (n_in != 25 || out_size != MTOK * DM || ws_size < WS_END) { fprintf(stderr, "kernel_launch: unexpected shapes (n_in %d, out %d, ws %zu)\n", n_in, out_size, ws_size); grid = -1; return; }
        int dev = 0, cus = 0, per_cu = 0;
        (void)hipGetDevice(&dev); (void)hipDeviceGetAttribute(&cus, hipDeviceAttributeMultiprocessorCount, dev);
        if (hipFuncSetAttribute((const void*)yoco_fwd, hipFuncAttributeMaxDynamicSharedMemorySize, LDS_BYTES) != hipSuccess) { fprintf(stderr, "kernel_launch: hipFuncSetAttribute failed\n"); grid = -1; return; }
        if (hipOccupancyMaxActiveBlocksPerMultiprocessor(&per_cu, (const void*)yoco_fwd, NTHREADS, LDS_BYTES) != hipSuccess || per_cu < 1) { fprintf(stderr, "kernel_launch: occupancy query says %d\n", per_cu); per_cu = 1; }
        (void)hipGetLastError();
        grid = cus * 1;
        if (grid <= 0) grid = 256;
    }
    if (grid < 0) return;
    if (hipMemsetAsync((char*)d_ws + WS_CTL, 0, CTL_BYTES, stream) != hipSuccess) { fprintf(stderr, "kernel_launch: memset failed\n"); return; }
    Args a{};
    for (int i = 0; i < 25; ++i) a.in[i] = (const float*)d_in[i];
    a.out = (float*)d_out; a.ws = (unsigned char*)d_ws; a.ph_lo = 0; a.ph_hi = 13;
    void* kargs[] = {&a};
    hipError_t e = hipLaunchCooperativeKernel((const void*)yoco_fwd, dim3(grid), dim3(NTHREADS), kargs, LDS_BYTES, stream);
    if (e != hipSuccess) fprintf(stderr, "cooperative launch failed: %s (grid %d)\n", hipGetErrorString(e), grid);
}
```

```cpp
#include <hip/hip_runtime.h>
#include <hip/hip_cooperative_groups.h>
#include <cstdio>
#include <cstdint>
namespace cg = cooperative_groups;

#define LAS __attribute__((address_space(3)))
#define DI __device__ __forceinline__
typedef unsigned short bf16_t;
typedef short bf16x8 __attribute__((ext_vector_type(8)));
typedef float f32x2 __attribute__((ext_vector_type(2)));
typedef float f32x4 __attribute__((ext_vector_type(4)));
typedef float f32x16 __attribute__((ext_vector_type(16)));
typedef unsigned u32x2 __attribute__((ext_vector_type(2)));
typedef unsigned u32x4 __attribute__((ext_vector_type(4)));
typedef __bf16 bf16x2_t __attribute__((ext_vector_type(2)));

constexpr int NB = 16, SEQ = 2048, DM = 1024, MTOK = NB * SEQ, FFD = 4096, NG = 64, NP = 64, NHEAD = 16, HD = 64;
constexpr int MODN = 14336;
constexpr float EPS = 1e-6f;
constexpr float QSCALE = 0.125f * 1.4426950408889634f;
constexpr int NWAVES = 8, NTHREADS = 512;
constexpr int LDS_BYTES = 143360;

constexpr size_t MiB = 1u << 20;
constexpr size_t WS_WGLU = 0, WS_W1 = 4 * MiB, WS_W2 = 20 * MiB, WS_WKV = 36 * MiB, WS_WQ = 40 * MiB, WS_WO = 42 * MiB;
constexpr size_t WS_MOD = 44 * MiB, WS_RSTD = 45 * MiB, WS_AB = 45 * MiB + 256 * 1024, WS_BOP = 45 * MiB + 512 * 1024, WS_CM = 45 * MiB + 768 * 1024;
constexpr size_t WS_YG = 48 * MiB, WS_H = 112 * MiB, WS_F = 176 * MiB;
constexpr size_t WS_Q = 176 * MiB, WS_K = 240 * MiB, WS_VT = 304 * MiB, WS_O = 368 * MiB, WS_CTL = 432 * MiB, CTL_BYTES = 16384, WS_END = 433 * MiB;

DI unsigned pk2(float lo, float hi) { f32x2 v = {lo, hi}; bf16x2_t b = __builtin_convertvector(v, bf16x2_t); return __builtin_bit_cast(unsigned, b); }
DI float wave_sum(float v) {
#pragma unroll
    for (int o = 1; o < 64; o <<= 1) v += __shfl_xor(v, o);
    return v;
}
#define LDS_WAIT() asm volatile("s_waitcnt lgkmcnt(0)" ::: "memory")

namespace pg8 {
constexpr int BM = 256, BK = 64, HALF = 128, HTB = HALF * BK * 2, STAGE_BYTES = 8 * HTB, NXCD = 8, WGM = 8;
__host__ __device__ __forceinline__ int lds_byte(int r, int c) { const int st = (r >> 4) * 2 + (c >> 5), rr = r & 15, cc = c & 31, ob = rr * 64 + cc * 2; return st * 1024 + (ob ^ (((ob >> 9) & 1) << 5)); }
__host__ __device__ __forceinline__ void stage_rc(int b, int& R, int& C) { const int st = b / 1024, sb = b % 1024, swz = sb ^ (((sb >> 9) & 1) << 5); R = (st >> 1) * 16 + swz / 64; C = (st & 1) * 32 + (swz % 64) / 2; }
__host__ __device__ __forceinline__ int perm32(int rho) { const int n = rho >> 4, i = rho & 15; return 8 * (i >> 2) + 4 * n + (i & 3); }
struct Unit { int pm, pn; };
struct Gemm { const bf16_t* A; const bf16_t* Bt; int M, N, K; };
struct StaticOrder {
    int nM, nN, nwg, G, c;
    __device__ void init(int M, int N, int G_, int c_) { nM = M / BM; nN = N / BM; nwg = nM * nN; G = G_; c = c_; }
    __device__ bool next(int i, Unit& u) const {
        const long L = (long)i * G + c; if (L >= nwg) return false;
        int wgid = (int)L; { const int q = nwg / NXCD, r = nwg % NXCD, xcd = wgid % NXCD, off = wgid / NXCD; wgid = (xcd < r ? xcd * (q + 1) : r * (q + 1) + (xcd - r) * q) + off; }
        const int nig = WGM * nN, gid = wgid / nig, fm = gid * WGM, gsz = (nM - fm) < WGM ? (nM - fm) : WGM;
        u.pm = fm + ((wgid % nig) % gsz); u.pn = (wgid % nig) / gsz; return true;
    }
};
template <class Epi>
__device__ __forceinline__ void gemm_phase(LAS unsigned char* lds, const Gemm g, const StaticOrder& S, const Epi& E) {
    const int tid = threadIdx.x, wid = __builtin_amdgcn_readfirstlane(tid >> 6), lane = tid & 63, wr = wid >> 2, wc = wid & 3, fr = lane & 15, fq = lane >> 4;
    const int K = g.K, nt = K / BK;
    unsigned voffA[2], voffB[2];
#pragma unroll
    for (int i = 0; i < 2; ++i) { int R, C; stage_rc(tid * 16 + i * 8192, R, C); const int Rb = Epi::PERM ? ((R & ~31) + perm32(R & 31)) : R;
        voffA[i] = (unsigned)(R * K + C) * 2u; voffB[i] = (unsigned)(Rb * K + C) * 2u; }
    const size_t kstep = (size_t)(BK * 2);
    const size_t hstep = (size_t)HALF * K * 2;
    const size_t tstep = 2 * hstep;
    const unsigned ldsw = (unsigned)wid * 1024u;
    const int aoff = lds_byte(wr * 64 + fr, fq * 8), boff = lds_byte(wc * 32 + fr, fq * 8);
#define PG8_SA(b, h) (((b) * 2 + (h)) * HTB)
#define PG8_SB(b, h) ((4 + (b) * 2 + (h)) * HTB)
#define PG8_STAGE(bufoff, gbase, voff) do { _Pragma("unroll") for (int _i = 0; _i < 2; ++_i) \
        __builtin_amdgcn_global_load_lds((const unsigned*)((const char*)(gbase) + (voff)[_i]), (LAS unsigned*)(lds + (bufoff) + ldsw + _i * 8192), 16, 0, 0); } while (0)
#define PG8_LDA(dst, b, h) do { _Pragma("unroll") for (int m = 0; m < 4; ++m) _Pragma("unroll") for (int k = 0; k < 2; ++k) dst[m][k] = *(const LAS bf16x8*)(lds + PG8_SA(b, h) + aoff + m * 2048 + k * 1024); } while (0)
#define PG8_LDB(dst, b, h) do { _Pragma("unroll") for (int n = 0; n < 2; ++n) _Pragma("unroll") for (int k = 0; k < 2; ++k) dst[n][k] = *(const LAS bf16x8*)(lds + PG8_SB(b, h) + boff + n * 2048 + k * 1024); } while (0)
#define PG8_MMA(ai, bj, At, Bt) do { __builtin_amdgcn_s_setprio(1); _Pragma("unroll") for (int m = 0; m < 4; ++m) _Pragma("unroll") for (int n = 0; n < 2; ++n) _Pragma("unroll") for (int k = 0; k < 2; ++k) \
        acc[ai][bj][m][n] = __builtin_amdgcn_mfma_f32_16x16x32_bf16(Bt[n][k], At[m][k], acc[ai][bj][m][n], 0, 0, 0); __builtin_amdgcn_s_setprio(0); } while (0)
#define PG8_WAIT_V(n) asm volatile("s_waitcnt vmcnt(" #n ")" ::: "memory")
#define PG8_WAIT_L(n) asm volatile("s_waitcnt lgkmcnt(" #n ")" ::: "memory")
#define PG8_BAR __builtin_amdgcn_s_barrier()
#define PG8_SCHED __builtin_amdgcn_sched_barrier(0)
    Unit cur, nxt; int ui = 0;
    if (!S.next(0, cur)) return;
    f32x4 acc[2][2][4][2];
#pragma unroll
    for (int a = 0; a < 2; ++a)
#pragma unroll
        for (int b = 0; b < 2; ++b)
#pragma unroll
            for (int m = 0; m < 4; ++m)
#pragma unroll
                for (int n = 0; n < 2; ++n) acc[a][b][m][n] = (f32x4){0.f, 0.f, 0.f, 0.f};
    bf16x8 At[4][2], B0[2][2], B1[2][2];
    const char* cA = (const char*)g.A + (size_t)cur.pm * tstep; const char* cB = (const char*)g.Bt + (size_t)cur.pn * tstep;
    PG8_STAGE(PG8_SB(0, 0), cB, voffB); PG8_STAGE(PG8_SB(0, 1), cB + hstep, voffB); PG8_STAGE(PG8_SA(0, 0), cA, voffA); PG8_STAGE(PG8_SA(0, 1), cA + hstep, voffA);
    if (wr == 1) PG8_BAR;
    PG8_WAIT_V(2); PG8_BAR;
    PG8_STAGE(PG8_SB(1, 0), cB + kstep, voffB); PG8_STAGE(PG8_SA(1, 0), cA + kstep, voffA); PG8_STAGE(PG8_SB(1, 1), cB + hstep + kstep, voffB);
    PG8_WAIT_V(6); PG8_BAR;
    for (;;) {
        const bool has_next = S.next(ui + 1, nxt);
        const char* nA = has_next ? (const char*)g.A + (size_t)nxt.pm * tstep : cA; const char* nB = has_next ? (const char*)g.Bt + (size_t)nxt.pn * tstep : cB;
        for (int t = 0; t < nt; t += 2) {
            const bool last = (t == nt - 2);
            const char* a1 = cA + (size_t)(t + 1) * kstep;
            const char* a2 = last ? nA : cA + (size_t)(t + 2) * kstep; const char* b2 = last ? nB : cB + (size_t)(t + 2) * kstep;
            const char* a3 = a2 + kstep; const char* b3 = b2 + kstep;
            PG8_LDB(B0, 0, 0); PG8_LDB(B1, 0, 1); PG8_SCHED; PG8_LDA(At, 0, 0); PG8_STAGE(PG8_SA(1, 1), a1 + hstep, voffA);
            PG8_WAIT_V(8); PG8_WAIT_L(0); PG8_BAR; PG8_MMA(0, 0, At, B0); PG8_MMA(0, 1, At, B1); PG8_BAR; PG8_SCHED;
            PG8_LDA(At, 0, 1); PG8_STAGE(PG8_SB(0, 0), b2, voffB); PG8_STAGE(PG8_SB(0, 1), b2 + hstep, voffB); PG8_STAGE(PG8_SA(0, 0), a2, voffA);
            PG8_WAIT_V(8); PG8_WAIT_L(0); PG8_BAR; PG8_MMA(1, 0, At, B0); PG8_MMA(1, 1, At, B1); PG8_BAR; PG8_SCHED;
            PG8_LDB(B0, 1, 0); PG8_LDB(B1, 1, 1); PG8_SCHED; PG8_LDA(At, 1, 0); PG8_STAGE(PG8_SA(0, 1), a2 + hstep, voffA);
            PG8_WAIT_V(8); PG8_WAIT_L(0); PG8_BAR; PG8_MMA(0, 0, At, B0); PG8_MMA(0, 1, At, B1); PG8_BAR; PG8_SCHED;
            PG8_LDA(At, 1, 1); PG8_STAGE(PG8_SB(1, 0), b3, voffB); PG8_STAGE(PG8_SB(1, 1), b3 + hstep, voffB); PG8_STAGE(PG8_SA(1, 0), a3, voffA);
            PG8_WAIT_V(8); PG8_WAIT_L(0); PG8_BAR; PG8_MMA(1, 0, At, B0); PG8_MMA(1, 1, At, B1); PG8_BAR; PG8_SCHED;
        }
        if (wr == 0) PG8_BAR;
        E(acc, cur, wr, wc, fr, fq);
        if (!has_next) break;
#pragma unroll
        for (int a = 0; a < 2; ++a)
#pragma unroll
            for (int b = 0; b < 2; ++b)
#pragma unroll
                for (int m = 0; m < 4; ++m)
#pragma unroll
                    for (int n = 0; n < 2; ++n) acc[a][b][m][n] = (f32x4){0.f, 0.f, 0.f, 0.f};
        cur = nxt; cA = nA; cB = nB; ++ui;
        if (wr == 1) PG8_BAR;
    }
    PG8_WAIT_V(0);
    PG8_BAR;
#undef PG8_SA
#undef PG8_SB
#undef PG8_STAGE
#undef PG8_LDA
#undef PG8_LDB
#undef PG8_MMA
#undef PG8_WAIT_V
#undef PG8_WAIT_L
#undef PG8_BAR
#undef PG8_SCHED
}

DI float sigmoidf_(float v) { return __builtin_amdgcn_rcpf(1.0f + __builtin_amdgcn_exp2f(-1.4426950408889634f * v)); }

struct EpiGlu {
    static constexpr bool PERM = false;
    const float* x; float* out; const float* ga;
    DI void operator()(const f32x4 (&acc)[2][2][4][2], const Unit& u, int wr, int wc, int fr, int fq) const {
        const int row0 = u.pm * BM + wr * 64 + fr, b = (u.pm * BM) >> 11, col0 = u.pn * 128 + wc * 32 + 4 * fq;
        f32x4 gv[2];
#pragma unroll
        for (int n = 0; n < 2; ++n) gv[n] = *(const f32x4*)(ga + (size_t)b * MODN + col0 + 16 * n);
#pragma unroll
        for (int ai = 0; ai < 2; ++ai)
#pragma unroll
            for (int m = 0; m < 4; ++m) { const size_t ro = (size_t)(row0 + ai * HALF + m * 16) * DM + col0;
#pragma unroll
                for (int n = 0; n < 2; ++n) { const f32x4 xin = *(const f32x4*)(x + ro + 16 * n); const f32x4 v = acc[ai][0][m][n], gt = acc[ai][1][m][n]; f32x4 o;
#pragma unroll
                    for (int j = 0; j < 4; ++j) o[j] = xin[j] + gv[n][j] * v[j] * sigmoidf_(gt[j]);
                    *(f32x4*)(out + ro + 16 * n) = o; } }
    }
};
struct EpiRelu2 {
    static constexpr bool PERM = true;
    bf16_t* O; int ldc;
    DI void operator()(const f32x4 (&acc)[2][2][4][2], const Unit& u, int wr, int wc, int fr, int fq) const {
        const int row0 = u.pm * BM + wr * 64 + fr, col0 = u.pn * BM + wc * 32 + 8 * fq;
#pragma unroll
        for (int ai = 0; ai < 2; ++ai)
#pragma unroll
            for (int m = 0; m < 4; ++m) { bf16_t* rowp = O + (size_t)(row0 + ai * HALF + m * 16) * ldc + col0;
#pragma unroll
                for (int bj = 0; bj < 2; ++bj) { f32x4 v0 = acc[ai][bj][m][0], v1 = acc[ai][bj][m][1];
#pragma unroll
                    for (int j = 0; j < 4; ++j) { const float a = fmaxf(v0[j], 0.f), c = fmaxf(v1[j], 0.f); v0[j] = a * a; v1[j] = c * c; }
                    u32x4 w; w.x = pk2(v0[0], v0[1]); w.y = pk2(v0[2], v0[3]); w.z = pk2(v1[0], v1[1]); w.w = pk2(v1[2], v1[3]);
                    *(u32x4*)(rowp + bj * HALF) = w; } }
    }
};
struct EpiRes {
    static constexpr bool PERM = false;
    float* io; const float* gate;
    DI void operator()(const f32x4 (&acc)[2][2][4][2], const Unit& u, int wr, int wc, int fr, int fq) const {
        const int row0 = u.pm * BM + wr * 64 + fr, b = (u.pm * BM) >> 11, col0 = u.pn * BM + wc * 32 + 4 * fq;
        f32x4 gv[2][2];
#pragma unroll
        for (int bj = 0; bj < 2; ++bj)
#pragma unroll
            for (int n = 0; n < 2; ++n) gv[bj][n] = *(const f32x4*)(gate + (size_t)b * MODN + col0 + bj * HALF + 16 * n);
#pragma unroll
        for (int ai = 0; ai < 2; ++ai)
#pragma unroll
            for (int m = 0; m < 4; ++m) { float* rp = io + (size_t)(row0 + ai * HALF + m * 16) * DM + col0;
#pragma unroll
                for (int bj = 0; bj < 2; ++bj)
#pragma unroll
                    for (int n = 0; n < 2; ++n) { const f32x4 bs = *(const f32x4*)(rp + bj * HALF + 16 * n); *(f32x4*)(rp + bj * HALF + 16 * n) = bs + gv[bj][n] * acc[ai][bj][m][n]; } }
    }
};
template <int MODE> struct EpiHeads {
    static constexpr bool PERM = true;
    bf16_t* Kb; bf16_t* VT; const float* ng;
    DI void operator()(const f32x4 (&acc)[2][2][4][2], const Unit& u, int wr, int wc, int fr, int fq) const {
        const int b = (u.pm * BM) >> 11, s0 = ((u.pm * BM) & (SEQ - 1)) + wr * 64 + fr;
        const bool isV = (MODE == 0) && (u.pn >= 4);
        const int h = 4 * (u.pn & 3) + wc;
        if (!isV) {
            const float gsc = (MODE == 1) ? QSCALE : 1.0f;
#pragma unroll
            for (int ai = 0; ai < 2; ++ai)
#pragma unroll
                for (int m = 0; m < 4; ++m) { float ss = 0.f;
#pragma unroll
                    for (int bj = 0; bj < 2; ++bj)
#pragma unroll
                        for (int n = 0; n < 2; ++n) { const f32x4 v = acc[ai][bj][m][n]; ss += (v[0] * v[0] + v[1] * v[1]) + (v[2] * v[2] + v[3] * v[3]); }
                    ss += __shfl_xor(ss, 16); ss += __shfl_xor(ss, 32);
                    const float rs = __builtin_amdgcn_rsqf(ss * (1.0f / 64.0f) + EPS) * gsc;
                    bf16_t* rp = Kb + ((size_t)(b * NHEAD + h) * SEQ + (s0 + ai * HALF + m * 16)) * HD + 8 * fq;
#pragma unroll
                    for (int bj = 0; bj < 2; ++bj) { const f32x4 g0 = *(const f32x4*)(ng + 32 * bj + 8 * fq), g1 = *(const f32x4*)(ng + 32 * bj + 8 * fq + 4);
                        const f32x4 v0 = acc[ai][bj][m][0] * rs * g0, v1 = acc[ai][bj][m][1] * rs * g1;
                        u32x4 w; w.x = pk2(v0[0], v0[1]); w.y = pk2(v0[2], v0[3]); w.z = pk2(v1[0], v1[1]); w.w = pk2(v1[2], v1[3]);
                        *(u32x4*)(rp + 32 * bj) = w; }
                    asm volatile("" ::: "memory"); }
        } else {
            const unsigned loff = (unsigned)(8 * fq * SEQ + fr);
            bf16_t* ub = VT + (size_t)(b * NHEAD + h) * HD * SEQ + (((u.pm * BM) & (SEQ - 1)) + wr * 64);
#pragma unroll
            for (int ai = 0; ai < 2; ++ai)
#pragma unroll
                for (int m = 0; m < 4; ++m) {
#pragma unroll
                    for (int bj = 0; bj < 2; ++bj)
#pragma unroll
                        for (int n = 0; n < 2; ++n) { const f32x4 v = acc[ai][bj][m][n];
#pragma unroll
                            for (int j = 0; j < 4; ++j) { bf16_t* up = ub + (size_t)(32 * bj + 4 * n + j) * SEQ + (ai * HALF + m * 16); up[loff] = (bf16_t)(pk2(v[j], 0.f) & 0xffffu); } }
                    asm volatile("" ::: "memory"); }
        }
    }
};
}

DI double dexp(double x) {
    const double n = __builtin_rint(x * 1.4426950408889634);
    double r = __builtin_fma(-n, 0.6931471805599453, x); r = __builtin_fma(-n, 2.3190468138462996e-17, r);
    double p = 1.0 / 6227020800.0;
    p = p * r + 1.0 / 479001600.0; p = p * r + 1.0 / 39916800.0; p = p * r + 1.0 / 3628800.0; p = p * r + 1.0 / 362880.0; p = p * r + 1.0 / 40320.0;
    p = p * r + 1.0 / 5040.0; p = p * r + 1.0 / 720.0; p = p * r + 1.0 / 120.0; p = p * r + 1.0 / 24.0; p = p * r + 1.0 / 6.0; p = p * r + 0.5; p = p * r + 1.0; p = p * r + 1.0;
    return __builtin_ldexp(p, (int)n);
}
DI void dsincos(double a, double& s, double& c) {
    const double q = __builtin_rint(a * 0.6366197723675814);
    double r = __builtin_fma(-q, 1.5707963267948966, a); r = __builtin_fma(-q, 6.123233995736766e-17, r);
    const int qi = ((int)q) & 3; const double r2 = r * r;
    double sp = -1.0 / 1307674368000.0; sp = sp * r2 + 1.0 / 6227020800.0; sp = sp * r2 - 1.0 / 39916800.0; sp = sp * r2 + 1.0 / 362880.0; sp = sp * r2 - 1.0 / 5040.0; sp = sp * r2 + 1.0 / 120.0; sp = sp * r2 - 1.0 / 6.0; sp = sp * r2 + 1.0; sp = sp * r;
    double cp = 1.0 / 20922789888000.0; cp = cp * r2 - 1.0 / 87178291200.0; cp = cp * r2 + 1.0 / 479001600.0; cp = cp * r2 - 1.0 / 3628800.0; cp = cp * r2 + 1.0 / 40320.0; cp = cp * r2 - 1.0 / 720.0; cp = cp * r2 + 1.0 / 24.0; cp = cp * r2 - 0.5; cp = cp * r2 + 1.0;
    s = (qi == 0) ? sp : (qi == 1) ? cp : (qi == 2) ? -sp : -cp;
    c = (qi == 0) ? cp : (qi == 1) ? -sp : (qi == 2) ? -cp : sp;
}

DI void transpose_item(const float* __restrict__ W, int K, int N, bf16_t* __restrict__ WT, int k0, int n0, int drow0, LAS float* scr, int lane) {
#pragma unroll 8
    for (int i = 0; i < 32; ++i) { const int kk = 2 * i + (lane >> 5); scr[kk * 33 + (lane & 31)] = W[(size_t)(k0 + kk) * N + n0 + (lane & 31)]; }
    LDS_WAIT();
    const int c = lane & 7;
#pragma unroll
    for (int j = 0; j < 4; ++j) { const int n = (lane >> 3) + 8 * j; const LAS float* s = scr + (8 * c) * 33 + n;
        u32x4 o; o.x = pk2(s[0 * 33], s[1 * 33]); o.y = pk2(s[2 * 33], s[3 * 33]); o.z = pk2(s[4 * 33], s[5 * 33]); o.w = pk2(s[6 * 33], s[7 * 33]);
        *(u32x4*)(WT + (size_t)(drow0 + n) * K + k0 + 8 * c) = o; }
    LDS_WAIT();
}
DI int map_rows(int mode, int n0) {
    if (mode == 1) { const int bj = n0 >> 10, rem = n0 & 1023; return 256 * (rem >> 7) + 128 * bj + (rem & 127); }
    if (mode == 2) { const int tile = n0 >> 8, off = n0 & 255; return 256 * tile + 128 * ((off & 63) >> 5) + 32 * (off >> 6); }
    return n0;
}

#define XB_TMO      128
#define XB_XCNT(j)  (256  + 64 * (j))
#define XB_XSUB(j)  (1280 + 64 * (j))
#define XB_XGEN(j)  (2304 + 64 * (j))
#define XB_TOP      3328
#define XB_TOPGEN   3392
#define XCD_BAR_WORDS 3456
#define XB_SPIN_CAP (1u << 22)
DI unsigned xb_ld(unsigned* p)              { return __hip_atomic_load(p, __ATOMIC_RELAXED, __HIP_MEMORY_SCOPE_AGENT); }
DI unsigned xb_add(unsigned* p, unsigned v) { return __hip_atomic_fetch_add(p, v, __ATOMIC_RELAXED, __HIP_MEMORY_SCOPE_AGENT); }
DI unsigned xb_xcc_id() { return (unsigned)__builtin_amdgcn_s_getreg((3 << 11) | 20) & 0xFu; }
#define XB_SPIN(cond, bar) do { unsigned _sp = 0; while (cond) { __builtin_amdgcn_s_sleep(1); \
    if ((++_sp & 255u) == 0u) { if (xb_ld(&(bar)[XB_TMO])) break; if (_sp > XB_SPIN_CAP) { atomicAdd(&(bar)[XB_TMO], 1u); break; } } } } while (0)
struct XcdBarrier { unsigned* bar; unsigned x; volatile LAS unsigned* st; };
DI XcdBarrier xcd_barrier_post(unsigned* bar, volatile LAS unsigned* st) {
    XcdBarrier b; b.bar = bar; b.x = xb_xcc_id(); b.st = st;
    if (threadIdx.x == 0) (void)xb_add(&bar[XB_XCNT(b.x)], 1u);
    return b;
}
DI void xcd_barrier_complete(unsigned* bar, unsigned x, unsigned& nloc, unsigned& nx) {
    const unsigned G = gridDim.x * gridDim.y * gridDim.z;
    unsigned sum, cnt, mine, sp = 0u;
    for (;;) {
        sum = 0u; cnt = 0u; mine = 0u;
#pragma unroll
        for (unsigned j = 0; j < 16; ++j) { const unsigned c = xb_ld(&bar[XB_XCNT(j)]); sum += c; cnt += (c > 0u) ? 1u : 0u; mine = (j == x) ? c : mine; }
        if (sum == G) break;
        __builtin_amdgcn_s_sleep(1);
        if ((++sp & 255u) == 0u) { if (xb_ld(&bar[XB_TMO])) break; if (sp > XB_SPIN_CAP) { atomicAdd(&bar[XB_TMO], 1u); break; } }
    }
    nloc = mine > 0u ? mine : 1u; nx = cnt > 0u ? cnt : 1u;
}
DI void xcd_barrier(const XcdBarrier& b) {
    asm volatile("s_waitcnt vmcnt(0)" ::: "memory");
    __syncthreads();
    if (threadIdx.x == 0) {
        unsigned* bar = b.bar;
        __builtin_amdgcn_s_waitcnt(0);
        unsigned nloc = b.st[0], nx = b.st[1];
        if (nloc == 0u) { xcd_barrier_complete(bar, b.x, nloc, nx); b.st[0] = nloc; b.st[1] = nx; }
        const unsigned old = xb_add(&bar[XB_XSUB(b.x)], 1u);
        const unsigned gen = old / nloc;
        if (old + 1u == (gen + 1u) * nloc) {
            __builtin_amdgcn_fence(__ATOMIC_RELEASE, "agent");
            asm volatile("s_waitcnt vmcnt(0)" ::: "memory");
            const unsigned og = xb_add(&bar[XB_TOP], 1u);
            const unsigned tg = og / nx;
            if (og + 1u == (tg + 1u) * nx) xb_add(&bar[XB_TOPGEN], 1u);
            else XB_SPIN(xb_ld(&bar[XB_TOPGEN]) == tg, bar);
            __builtin_amdgcn_fence(__ATOMIC_ACQUIRE, "agent");
            xb_add(&bar[XB_XGEN(b.x)], 1u);
            asm volatile("s_waitcnt vmcnt(0)" ::: "memory");
        } else {
            XB_SPIN(xb_ld(&bar[XB_XGEN(b.x)]) == gen, bar);
            __builtin_amdgcn_fence(__ATOMIC_ACQUIRE, "agent");
            asm volatile("s_waitcnt vmcnt(0)" ::: "memory");
        }
    }
    __syncthreads();
}

struct Args { const float* in[25]; float* out; unsigned char* ws; int ph_lo, ph_hi; };

__global__ void __launch_bounds__(NTHREADS, 2) yoco_fwd(Args args) {
    extern __shared__ __attribute__((aligned(16))) unsigned char lds_raw[];
    LAS unsigned char* lds = (LAS unsigned char*)lds_raw;
    cg::grid_group grid = cg::this_grid();
    const int tid = threadIdx.x, lane = tid & 63, wave = __builtin_amdgcn_readfirstlane(tid >> 6);
    const int G = gridDim.x, blk = blockIdx.x;
    const int gw = blk * NWAVES + wave, NGW = G * NWAVES;
    unsigned char* ws = args.ws;
    const float* x_in = args.in[0];
    float* X = args.out;
    bf16_t* Wglu = (bf16_t*)(ws + WS_WGLU); bf16_t* W1t = (bf16_t*)(ws + WS_W1); bf16_t* W2t = (bf16_t*)(ws + WS_W2);
    bf16_t* Wkv = (bf16_t*)(ws + WS_WKV); bf16_t* Wq = (bf16_t*)(ws + WS_WQ); bf16_t* Wo = (bf16_t*)(ws + WS_WO);
    float* modv = (float*)(ws + WS_MOD); float* rstd0 = (float*)(ws + WS_RSTD);
    f32x2* abv = (f32x2*)(ws + WS_AB); bf16_t* Bop = (bf16_t*)(ws + WS_BOP); bf16_t* Cm = (bf16_t*)(ws + WS_CM);
    bf16_t* Yg = (bf16_t*)(ws + WS_YG); bf16_t* Hb = (bf16_t*)(ws + WS_H); bf16_t* Fb = (bf16_t*)(ws + WS_F);
    bf16_t* Qb = (bf16_t*)(ws + WS_Q); bf16_t* Kb = (bf16_t*)(ws + WS_K); bf16_t* VT = (bf16_t*)(ws + WS_VT); bf16_t* Ob = (bf16_t*)(ws + WS_O);
    const int lo = args.ph_lo, hi_ph = args.ph_hi;
#ifndef PHMASK
#define PHMASK 0x1fff
#endif
#ifndef ATT_REP
#define ATT_REP 1
#endif
#ifndef S5_REP
#define S5_REP 1
#endif
#define PH(k) if (IN(k))
#define IN(k) (((PHMASK >> (k)) & 1) && lo <= (k) && (k) < hi_ph)
    volatile LAS unsigned* MISC = (volatile LAS unsigned*)(lds + LDS_BYTES - 256);
    if (tid < 16) MISC[tid] = 0u;
    __syncthreads();
    const XcdBarrier xbar = xcd_barrier_post((unsigned*)(ws + WS_CTL), MISC + 8);
#define SEAM(k) do { if (IN(k) && IN((k) + 1)) { if ((k) == 0) grid.sync(); else xcd_barrier(xbar); } } while (0)

    PH(0) {
        {
            LAS float* sc = (LAS float*)lds;
            LAS float* red = (LAS float*)(lds + 65536);
            const float* cvec = args.in[1];
            bool have_sc = false;
            for (int cb = blk; cb < MODN / 64; cb += G) {
                if (!have_sc) {
                    for (int i = tid; i < NB * DM; i += NTHREADS) { const float v = cvec[i]; sc[(i & 1023) * 16 + (i >> 10)] = v / (1.0f + __expf(-v)); }
                    __syncthreads(); have_sc = true;
                }
                const int e = cb * 64 + lane;
                const float* Wp; int stride; const float* bias;
                if (e < 12288) { const int l = e / 6144, ee = e - l * 6144; Wp = args.in[2] + (size_t)l * DM * 6144 + ee; stride = 6144; bias = args.in[3] + l * 6144 + ee; }
                else { const int ee = e - 12288; Wp = args.in[17] + ee; stride = 2048; bias = args.in[18] + ee; }
                float a[16];
#pragma unroll
                for (int b = 0; b < 16; ++b) a[b] = 0.f;
                const int d0 = wave * 128;
#pragma unroll 4
                for (int d = 0; d < 128; ++d) { const float w = Wp[(size_t)(d0 + d) * stride];
                    const LAS f32x4* sp = (const LAS f32x4*)(sc + (d0 + d) * 16);
#pragma unroll
                    for (int q = 0; q < 4; ++q) { const f32x4 s4 = sp[q]; a[4 * q] += w * s4[0]; a[4 * q + 1] += w * s4[1]; a[4 * q + 2] += w * s4[2]; a[4 * q + 3] += w * s4[3]; } }
#pragma unroll
                for (int b = 0; b < 16; ++b) red[(wave * 16 + b) * 64 + lane] = a[b];
                __syncthreads();
                for (int o = tid; o < 1024; o += NTHREADS) { const int b = o >> 6, cl = o & 63; float s = 0.f;
#pragma unroll
                    for (int w8 = 0; w8 < 8; ++w8) s += red[(w8 * 16 + b) * 64 + cl];
                    const int ee = cb * 64 + cl; const float bs = (ee < 12288) ? args.in[3][ee] : args.in[18][ee - 12288];
                    modv[(size_t)b * MODN + ee] = s + bs; }
                __syncthreads();
                (void)bias;
            }
            __syncthreads();
        }
        for (int i = blk * NTHREADS + tid; i < NG * NP; i += G * NTHREADS) {
            const int g = i >> 6, p = i & 63;
            const double lre = (double)args.in[8][i], lim = (double)args.in[9][i], dt = dexp((double)args.in[10][g]);
            const double mag = dexp(lre * dt); double sn, cs; dsincos(lim * dt, sn, cs);
            const double are = mag * cs, aim = mag * sn, den = lre * lre + lim * lim, nr = are - 1.0, ni = aim;
            const double fre = (nr * lre + ni * lim) / den, fim = (ni * lre - nr * lim) / den;
            abv[i] = (f32x2){(float)are, (float)aim};
            const float* bre = args.in[11] + (size_t)i * 16; const float* bim = args.in[12] + (size_t)i * 16;
#pragma unroll
            for (int h = 0; h < 16; h += 2) {
                const double br0 = bre[h], bi0 = bim[h], br1 = bre[h + 1], bi1 = bim[h + 1];
                *(unsigned*)(Bop + ((size_t)(g * 128 + 2 * p) * 16 + h)) = pk2((float)(fre * br0 - fim * bi0), (float)(fre * br1 - fim * bi1));
                *(unsigned*)(Bop + ((size_t)(g * 128 + 2 * p + 1) * 16 + h)) = pk2((float)(fre * bi0 + fim * br0), (float)(fre * bi1 + fim * br1));
            }
#pragma unroll
            for (int h = 0; h < 16; ++h) {
                const float cr = args.in[13][(size_t)(g * 16 + h) * 64 + p], ci = args.in[14][(size_t)(g * 16 + h) * 64 + p];
                *(unsigned*)(Cm + ((size_t)(g * 16 + h) * 128 + 2 * p)) = pk2(cr, -ci);
            }
        }
        for (int row = gw; row < MTOK; row += NGW) {
            const f32x4* xr = (const f32x4*)(x_in + (size_t)row * DM) + lane; float ss = 0.f;
#pragma unroll
            for (int j = 0; j < 4; ++j) { const f32x4 v = xr[64 * j]; ss += (v[0] * v[0] + v[1] * v[1]) + (v[2] * v[2] + v[3] * v[3]); }
            ss = wave_sum(ss);
            if (lane == 0) rstd0[row] = 1.0f / sqrtf(ss * (1.0f / DM) + EPS);
        }
    }
    SEAM(0);

    PH(1) {
        if (wave < 4) {
            LAS float* BUl = (LAS float*)(lds + wave * 25600);
            LAS unsigned* Sl = (LAS unsigned*)(lds + wave * 25600 + 16384);
            const int r32 = lane & 31, hi = lane >> 5, fr = lane & 15, fq = lane >> 4;
            const float* sh_a = modv + 0 * 1024; const float* sc_a = modv + 1 * 1024; const float* gmix = args.in[4]; const float* dsk = args.in[15];
            for (int pp = blk * 4 + wave; pp < NB * NG * S5_REP; pp += G * 4) {
                const int pair = pp & 1023;
                const int b = pair >> 6, g = pair & 63;
                float gs[8], shv[8];
#pragma unroll
                for (int j = 0; j < 8; ++j) { const int ch = 16 * g + 8 * hi + j; gs[j] = gmix[ch] * (1.0f + sc_a[(size_t)b * MODN + ch]); shv[j] = sh_a[(size_t)b * MODN + ch]; }
                float gs4[4], sh4[4], d4[4];
#pragma unroll
                for (int j = 0; j < 4; ++j) { const int ch = 16 * g + 4 * fq + j; gs4[j] = gmix[ch] * (1.0f + sc_a[(size_t)b * MODN + ch]); sh4[j] = sh_a[(size_t)b * MODN + ch]; d4[j] = dsk[ch]; }
                bf16x8 bfrag[4], cfrag[4];
#pragma unroll
                for (int pt = 0; pt < 4; ++pt) bfrag[pt] = *(const bf16x8*)(Bop + ((size_t)(g * 128 + 32 * pt + r32) * 16 + 8 * hi));
#pragma unroll
                for (int ks = 0; ks < 4; ++ks) cfrag[ks] = *(const bf16x8*)(Cm + ((size_t)(g * 16 + fr) * 128 + 32 * ks + 8 * fq));
                const f32x2 ab = abv[g * 64 + lane];
                float s_re = 0.f, s_im = 0.f;
                const float* xb = x_in + (size_t)b * SEQ * DM + 16 * g;
                const float* rsb = rstd0 + (size_t)b * SEQ;
                f32x4 nx0 = *(const f32x4*)(xb + (size_t)r32 * DM + 8 * hi), nx1 = *(const f32x4*)(xb + (size_t)r32 * DM + 8 * hi + 4); float nrs = rsb[r32];
                for (int c = 0; c < SEQ / 32; ++c) {
                    const int t0 = 32 * c;
                    const f32x4 x0 = nx0, x1 = nx1; const float rs = nrs;
                    if (c + 1 < SEQ / 32) { const float* xp = xb + (size_t)(t0 + 32 + r32) * DM + 8 * hi; nx0 = *(const f32x4*)xp; nx1 = *(const f32x4*)(xp + 4); nrs = rsb[t0 + 32 + r32]; }
                    f32x4 exv[2]; float ers[2];
#pragma unroll
                    for (int nt = 0; nt < 2; ++nt) { exv[nt] = *(const f32x4*)(xb + (size_t)(t0 + 16 * nt + fr) * DM + 4 * fq); ers[nt] = rsb[t0 + 16 * nt + fr]; }
                    u32x4 up;
                    up.x = pk2(x0[0] * rs * gs[0] + shv[0], x0[1] * rs * gs[1] + shv[1]); up.y = pk2(x0[2] * rs * gs[2] + shv[2], x0[3] * rs * gs[3] + shv[3]);
                    up.z = pk2(x1[0] * rs * gs[4] + shv[4], x1[1] * rs * gs[5] + shv[5]); up.w = pk2(x1[2] * rs * gs[6] + shv[6], x1[3] * rs * gs[7] + shv[7]);
                    const bf16x8 ua = __builtin_bit_cast(bf16x8, up);
#pragma unroll
                    for (int pt = 0; pt < 4; ++pt) {
                        f32x16 z = {0.f, 0.f, 0.f, 0.f, 0.f, 0.f, 0.f, 0.f, 0.f, 0.f, 0.f, 0.f, 0.f, 0.f, 0.f, 0.f};
                        z = __builtin_amdgcn_mfma_f32_32x32x16_bf16(ua, bfrag[pt], z, 0, 0, 0);
#pragma unroll
                        for (int i = 0; i < 16; ++i) BUl[((i & 3) + 8 * (i >> 2) + 4 * hi) * 128 + 32 * pt + r32] = z[i];
                    }
                    LDS_WAIT();
                    f32x2 buv[32];
#pragma unroll
                    for (int t = 0; t < 32; ++t) buv[t] = *(const LAS f32x2*)(BUl + t * 128 + 2 * lane);
#pragma unroll
                    for (int t = 0; t < 32; ++t) {
                        const float nr = ab[0] * s_re - ab[1] * s_im + buv[t][0];
                        const float ni = ab[0] * s_im + ab[1] * s_re + buv[t][1];
                        s_re = nr; s_im = ni;
                        Sl[t * 68 + lane] = pk2(s_re, s_im);
                    }
                    LDS_WAIT();
#pragma unroll
                    for (int nt = 0; nt < 2; ++nt) {
                        f32x4 acc = {0.f, 0.f, 0.f, 0.f};
#pragma unroll
                        for (int ks = 0; ks < 4; ++ks) { const bf16x8 sf = *(const LAS bf16x8*)((const LAS unsigned char*)Sl + (16 * nt + fr) * 272 + 64 * ks + 16 * fq);
                            acc = __builtin_amdgcn_mfma_f32_16x16x32_bf16(cfrag[ks], sf, acc, 0, 0, 0); }
                        const int t = t0 + 16 * nt + fr;
                        const f32x4 xv = exv[nt]; const float rs2 = ers[nt];
                        float yo[4];
#pragma unroll
                        for (int j = 0; j < 4; ++j) { const float u = xv[j] * rs2 * gs4[j] + sh4[j]; const float y = acc[j] + d4[j] * u;
                            const float kk = 0.7978845608028654f * (y + 0.044715f * y * y * y);
                            yo[j] = y * __builtin_amdgcn_rcpf(1.0f + __builtin_amdgcn_exp2f(-2.0f * 1.4426950408889634f * kk)); }
                        u32x2 o2; o2.x = pk2(yo[0], yo[1]); o2.y = pk2(yo[2], yo[3]);
                        *(u32x2*)(Yg + ((size_t)(b * SEQ + t) * DM + 16 * g + 4 * fq)) = o2;
                    }
                    LDS_WAIT();
                }
            }
        } else {
        {
            LAS float* scr = (LAS float*)(lds + 102400 + (wave - 4) * 8448);
            constexpr int I_GLU = 16 * 64, I_W1 = 16 * 128, I_W2 = 64 * 32, I_KV = 16 * 64, I_Q = 16 * 32, I_O = 16 * 32;
            constexpr int NITEMS = I_GLU + 2 * I_W1 + 2 * I_W2 + I_KV + I_Q + I_O;
            for (int it = blk * 4 + (wave - 4); it < NITEMS; it += G * 4) {
                int r = it; const float* W; bf16_t* WT; int K, N, mode;
                if (r < I_GLU) { W = args.in[16]; WT = Wglu; K = DM; N = 2 * DM; mode = 1; }
                else if ((r -= I_GLU) < 2 * I_W1) { const int l = r / I_W1; r -= l * I_W1; W = args.in[6] + (size_t)l * DM * FFD; WT = W1t + (size_t)l * DM * FFD; K = DM; N = FFD; mode = 0; }
                else if ((r -= 2 * I_W1) < 2 * I_W2) { const int l = r / I_W2; r -= l * I_W2; W = args.in[7] + (size_t)l * DM * FFD; WT = W2t + (size_t)l * DM * FFD; K = FFD; N = DM; mode = 0; }
                else if ((r -= 2 * I_W2) < I_KV) { W = args.in[20]; WT = Wkv; K = DM; N = 2 * DM; mode = 2; }
                else if ((r -= I_KV) < I_Q) { W = args.in[22]; WT = Wq; K = DM; N = DM; mode = 2; }
                else { r -= I_Q; W = args.in[24]; WT = Wo; K = DM; N = DM; mode = 0; }
                const int nblk = N / 32, kb = r / nblk, nb = r - kb * nblk;
                transpose_item(W, K, N, WT, 64 * kb, 32 * nb, map_rows(mode, 32 * nb), scr, lane);
            }
        }
        }
    }
    SEAM(1);

    PH(2) {
        pg8::Gemm g{Yg, Wglu, MTOK, 2 * DM, DM}; pg8::StaticOrder S; S.init(MTOK, 2 * DM, G, blk);
        pg8::EpiGlu E{x_in, X, modv + 2 * 1024};
        pg8::gemm_phase<pg8::EpiGlu>(lds, g, S, E);
    }
    SEAM(2);

#define NORM_ROW(Gv, SH, SC, OUT) do { \
        _Pragma("unroll") for (int j = 0; j < 4; ++j) { const int col = 4 * lane + 256 * j; \
            const f32x4 gg = *(const f32x4*)((Gv) + col), s4 = *(const f32x4*)((SC) + (size_t)b * MODN + col), t4 = *(const f32x4*)((SH) + (size_t)b * MODN + col); \
            const f32x4 o = v[j] * rs * gg * (1.0f + s4) + t4; u32x2 w; w.x = pk2(o[0], o[1]); w.y = pk2(o[2], o[3]); \
            *(u32x2*)((OUT) + (size_t)row * DM + col) = w; } } while (0)
#define NORM_PHASE(BODY) do { for (int row = gw; row < MTOK; row += NGW) { const int b = row >> 11; \
        const f32x4* xr = (const f32x4*)(X + (size_t)row * DM) + lane; f32x4 v[4]; float ss = 0.f; \
        _Pragma("unroll") for (int j = 0; j < 4; ++j) { v[j] = xr[64 * j]; ss += (v[j][0] * v[j][0] + v[j][1] * v[j][1]) + (v[j][2] * v[j][2] + v[j][3] * v[j][3]); } \
        const float rs = 1.0f / sqrtf(wave_sum(ss) * (1.0f / DM) + EPS); BODY } } while (0)

    PH(3) { NORM_PHASE( NORM_ROW(args.in[5], modv + 3 * 1024, modv + 4 * 1024, Hb); ); }
    SEAM(3);
    PH(4) {
        pg8::Gemm g{Hb, W1t, MTOK, FFD, DM}; pg8::StaticOrder S; S.init(MTOK, FFD, G, blk);
        pg8::EpiRelu2 E{Fb, FFD};
        pg8::gemm_phase<pg8::EpiRelu2>(lds, g, S, E);
    }
    SEAM(4);
    PH(5) {
        pg8::Gemm g{Fb, W2t, MTOK, DM, FFD}; pg8::StaticOrder S; S.init(MTOK, DM, G, blk);
        pg8::EpiRes E{X, modv + 5 * 1024};
        pg8::gemm_phase<pg8::EpiRes>(lds, g, S, E);
    }
    SEAM(5);
    PH(6) { NORM_PHASE( NORM_ROW(args.in[19], modv + 12288, modv + 13312, Hb); NORM_ROW(args.in[4] + DM, modv + 6144, modv + 6144 + 1024, Yg); ); }
    SEAM(6);
    PH(7) {
#ifndef P7_NO_KV
        { pg8::Gemm g{Hb, Wkv, MTOK, 2 * DM, DM}; pg8::StaticOrder S; S.init(MTOK, 2 * DM, G, blk);
          pg8::EpiHeads<0> E{Kb, VT, args.in[21]};
          pg8::gemm_phase<pg8::EpiHeads<0>>(lds, g, S, E); }
#endif
#ifndef P7_NO_Q
        { pg8::Gemm g{Yg, Wq, MTOK, DM, DM}; pg8::StaticOrder S; S.init(MTOK, DM, G, blk);
          pg8::EpiHeads<1> E{Qb, nullptr, args.in[23]};
          pg8::gemm_phase<pg8::EpiHeads<1>>(lds, g, S, E); }
#endif
    }
    SEAM(7);

    PH(8) {
        const int r32 = lane & 31, hi = lane >> 5;
        const int kperm = 16 * ((r32 >> 2) & 1) + 4 * (r32 >> 3) + (r32 & 3);
        for (int uu = blk; uu < NB * NHEAD * 4 * ATT_REP; uu += G) {
            const int u = uu & 1023; const int rr = u >> 8, bl = u & 255, xcd = bl & 7, cc = bl >> 3;
            const int bh = xcd * 32 + 8 * rr + (cc >> 2), qb = (cc + rr) & 3;
            const int qtA = 16 * qb + wave, qtB = 16 * qb + 15 - wave;
            const bf16_t* Qh = Qb + (size_t)bh * SEQ * HD; const bf16_t* Kh = Kb + (size_t)bh * SEQ * HD; const bf16_t* Vh = VT + (size_t)bh * HD * SEQ;
            bf16x8 qA[4], qB[4];
#pragma unroll
            for (int d0 = 0; d0 < 4; ++d0) { qA[d0] = *(const bf16x8*)(Qh + (size_t)(32 * qtA + r32) * HD + 16 * d0 + 8 * hi); qB[d0] = *(const bf16x8*)(Qh + (size_t)(32 * qtB + r32) * HD + 16 * d0 + 8 * hi); }
            f32x16 oA0, oA1, oB0, oB1;
#pragma unroll
            for (int i = 0; i < 16; ++i) { oA0[i] = 0.f; oA1[i] = 0.f; oB0[i] = 0.f; oB1[i] = 0.f; }
            float carA = 1.f, carB = 1.f;
#define ATT_TILE(KF, VF, QF, O0, O1, CAR, DIAG) do { \
                f32x16 s_ = {0.f, 0.f, 0.f, 0.f, 0.f, 0.f, 0.f, 0.f, 0.f, 0.f, 0.f, 0.f, 0.f, 0.f, 0.f, 0.f}; \
                _Pragma("unroll") for (int d0 = 0; d0 < 4; ++d0) s_ = __builtin_amdgcn_mfma_f32_32x32x16_bf16(KF[d0], QF[d0], s_, 0, 0, 0); \
                float be_[16], fl_[16]; \
                _Pragma("unroll") for (int i = 0; i < 16; ++i) { const float e_ = __builtin_amdgcn_exp2f(-s_[i]); const float r_ = __builtin_amdgcn_rcpf(1.0f + e_); be_[i] = r_; fl_[i] = e_ * r_; \
                    if (DIAG) { if (16 * hi + i >= r32) { be_[i] = 0.f; fl_[i] = 1.f; } } } \
                float T_ = ((fl_[0] * fl_[1]) * (fl_[2] * fl_[3])) * ((fl_[4] * fl_[5]) * (fl_[6] * fl_[7])); \
                T_ *= ((fl_[8] * fl_[9]) * (fl_[10] * fl_[11])) * ((fl_[12] * fl_[13]) * (fl_[14] * fl_[15])); \
                const auto sw_ = __builtin_amdgcn_permlane32_swap(__float_as_uint(T_), __float_as_uint(T_), false, false); \
                const float Tlo_ = __uint_as_float(sw_[0]), Thi_ = __uint_as_float(sw_[1]); \
                float run_ = CAR * (hi ? 1.0f : Thi_); \
                _Pragma("unroll") for (int i = 15; i >= 0; --i) { be_[i] *= run_; run_ *= fl_[i]; } \
                CAR *= Tlo_ * Thi_; \
                u32x4 p0_, p1_; \
                p0_.x = pk2(be_[0], be_[1]); p0_.y = pk2(be_[2], be_[3]); p0_.z = pk2(be_[4], be_[5]); p0_.w = pk2(be_[6], be_[7]); \
                p1_.x = pk2(be_[8], be_[9]); p1_.y = pk2(be_[10], be_[11]); p1_.z = pk2(be_[12], be_[13]); p1_.w = pk2(be_[14], be_[15]); \
                const bf16x8 w0_ = __builtin_bit_cast(bf16x8, p0_), w1_ = __builtin_bit_cast(bf16x8, p1_); \
                O0 = __builtin_amdgcn_mfma_f32_32x32x16_bf16(VF[0][0], w0_, O0, 0, 0, 0); O0 = __builtin_amdgcn_mfma_f32_32x32x16_bf16(VF[0][1], w1_, O0, 0, 0, 0); \
                O1 = __builtin_amdgcn_mfma_f32_32x32x16_bf16(VF[1][0], w0_, O1, 0, 0, 0); O1 = __builtin_amdgcn_mfma_f32_32x32x16_bf16(VF[1][1], w1_, O1, 0, 0, 0); \
            } while (0)
#define ATT_LOAD(KF, VF, KT) do { \
                _Pragma("unroll") for (int d0 = 0; d0 < 4; ++d0) KF[d0] = *(const bf16x8*)(Kh + (size_t)(32 * (KT) + kperm) * HD + 16 * d0 + 8 * hi); \
                _Pragma("unroll") for (int dt = 0; dt < 2; ++dt) _Pragma("unroll") for (int ks = 0; ks < 2; ++ks) VF[dt][ks] = *(const bf16x8*)(Vh + (size_t)(32 * dt + r32) * SEQ + 32 * (KT) + 16 * hi + 8 * ks); \
            } while (0)
#define ATT_STEP(KF, VF, KFN, VFN, KT) do { \
                if ((KT) > 0) ATT_LOAD(KFN, VFN, (KT) - 1); \
                ATT_TILE(KF, VF, qB, oB0, oB1, carB, false); \
                if ((KT) <= qtA) { if ((KT) == qtA) ATT_TILE(KF, VF, qA, oA0, oA1, carA, true); else ATT_TILE(KF, VF, qA, oA0, oA1, carA, false); } \
            } while (0)
            bf16x8 kf0[4], vf0[2][2], kf1[4], vf1[2][2];
            ATT_LOAD(kf0, vf0, qtB);
            ATT_LOAD(kf1, vf1, qtB - 1);
            ATT_TILE(kf0, vf0, qB, oB0, oB1, carB, true);
            for (int kt = qtB - 1; kt >= 0; kt -= 2) {
                ATT_STEP(kf1, vf1, kf0, vf0, kt);
                if (kt - 1 >= 0) ATT_STEP(kf0, vf0, kf1, vf1, kt - 1);
            }
#undef ATT_STEP
#undef ATT_LOAD
#undef ATT_TILE
            const int b = bh >> 4, h = bh & 15;
#define ATT_STORE(QT, O0, O1) do { bf16_t* op = Ob + ((size_t)(b * SEQ + 32 * (QT) + r32) * DM + h * HD + 4 * hi); \
                _Pragma("unroll") for (int i4 = 0; i4 < 4; ++i4) { u32x2 w; w.x = pk2(O0[4 * i4], O0[4 * i4 + 1]); w.y = pk2(O0[4 * i4 + 2], O0[4 * i4 + 3]); *(u32x2*)(op + 8 * i4) = w; \
                    u32x2 w2; w2.x = pk2(O1[4 * i4], O1[4 * i4 + 1]); w2.y = pk2(O1[4 * i4 + 2], O1[4 * i4 + 3]); *(u32x2*)(op + 32 + 8 * i4) = w2; } } while (0)
            ATT_STORE(qtA, oA0, oA1); ATT_STORE(qtB, oB0, oB1);
#undef ATT_STORE
        }
    }
    SEAM(8);
    PH(9) {
        pg8::Gemm g{Ob, Wo, MTOK, DM, DM}; pg8::StaticOrder S; S.init(MTOK, DM, G, blk);
        pg8::EpiRes E{X, modv + 6144 + 2 * 1024};
        pg8::gemm_phase<pg8::EpiRes>(lds, g, S, E);
    }
    SEAM(9);
    PH(10) { NORM_PHASE( NORM_ROW(args.in[5] + DM, modv + 6144 + 3 * 1024, modv + 6144 + 4 * 1024, Hb); ); }
    SEAM(10);
    PH(11) {
        pg8::Gemm g{Hb, W1t + (size_t)DM * FFD, MTOK, FFD, DM}; pg8::StaticOrder S; S.init(MTOK, FFD, G, blk);
        pg8::EpiRelu2 E{Fb, FFD};
        pg8::gemm_phase<pg8::EpiRelu2>(lds, g, S, E);
    }
    SEAM(11);
    PH(12) {
        pg8::Gemm g{Fb, W2t + (size_t)DM * FFD, MTOK, DM, FFD}; pg8::StaticOrder S; S.init(MTOK, DM, G, blk);
        pg8::EpiRes E{X, modv + 6144 + 5 * 1024};
        pg8::gemm_phase<pg8::EpiRes>(lds, g, S, E);
    }
#undef IN
#undef SEAM
}

extern "C" void kernel_launch(void* const* d_in, const int* in_sizes, int n_in, void* d_out, int out_size, void* d_ws, size_t ws_size, hipStream_t stream) {
    static int grid = 0;
    if (grid == 0) {
        if (n_in != 25 || out_size != MTOK * DM || ws_size < WS_END) { fprintf(stderr, "kernel_launch: unexpected shapes (n_in %d, out %d, ws %zu)\n", n_in, out_size, ws_size); grid = -1; return; }
        int dev = 0, cus = 0, per_cu = 0;
        (void)hipGetDevice(&dev); (void)hipDeviceGetAttribute(&cus, hipDeviceAttributeMultiprocessorCount, dev);
        if (hipFuncSetAttribute((const void*)yoco_fwd, hipFuncAttributeMaxDynamicSharedMemorySize, LDS_BYTES) != hipSuccess) { fprintf(stderr, "kernel_launch: hipFuncSetAttribute failed\n"); grid = -1; return; }
        if (hipOccupancyMaxActiveBlocksPerMultiprocessor(&per_cu, (const void*)yoco_fwd, NTHREADS, LDS_BYTES) != hipSuccess || per_cu < 1) { fprintf(stderr, "kernel_launch: occupancy query says %d\n", per_cu); per_cu = 1; }
        (void)hipGetLastError();
        grid = cus * 1;
        if (grid <= 0) grid = 256;
    }
    if (grid < 0) return;
    if (hipMemsetAsync((char*)d_ws + WS_CTL, 0, CTL_BYTES, stream) != hipSuccess) { fprintf(stderr, "kernel_launch: memset failed\n"); return; }
    Args a{};
    for (int i = 0; i < 25; ++i) a.in[i] = (const float*)d_in[i];
    a.out = (float*)d_out; a.ws = (unsigned char*)d_ws; a.ph_lo = 0; a.ph_hi = 13;
    void* kargs[] = {&a};
    hipError_t e = hipLaunchCooperativeKernel((const void*)yoco_fwd, dim3(grid), dim3(NTHREADS), kargs, LDS_BYTES, stream);
    if (e != hipSuccess) fprintf(stderr, "cooperative launch failed: %s (grid %d)\n", hipGetErrorString(e), grid);
}
```
